# Optimizing an MI355X kernel written in HIP

```python
import jax, jax.numpy as jnp
from jax import lax
import numpy as np

D_MODEL = 1024
BATCH = 16
SEQ = 2048
DEPTH = 1

D_MIX = D_MODEL
ML_HEADS = 4
ML_DH = 128
ML_WIDTH = ML_HEADS * ML_DH
ML_CHUNK = 64
CONV_K = 4
NSA_HEADS = 8
NSA_KV_HEADS = 2
NSA_DH = 64
NSA_HPG = NSA_HEADS // NSA_KV_HEADS
NSA_WIDTH = NSA_HEADS * NSA_DH
NSA_KV_WIDTH = NSA_KV_HEADS * NSA_DH
CMP_BLOCK = 32
CMP_STRIDE = 16
CMP_HIDDEN = 256
SLC_BLOCK = 64
SLC_TOPN = 16
WINDOW = 512
Q_BLOCK = 128
N_BRANCH = 3
D_IN = 4 * ML_WIDTH + 2 * ML_HEADS + NSA_WIDTH + 6 * NSA_KV_WIDTH + NSA_HEADS * N_BRANCH
D_FF = 2816
EPS = 1e-6
NEG = -1e30
FORCE = 1e30

kernel_name = 'hybrid_mlstm_nsa_macaron'


def rmsnorm(x, g):
    xf = x.astype(jnp.float32)
    y = xf * lax.rsqrt(jnp.mean(xf * xf, axis=-1, keepdims=True) + EPS)
    return (y * g.astype(jnp.float32)).astype(x.dtype)


def swiglu(x, w1, w3, w2):
    return (jax.nn.silu(x @ w1) * (x @ w3)) @ w2


def causal_conv(x, w):
    k, c = w.shape
    return lax.conv_general_dilated(x, w[:, None, :].astype(x.dtype), window_strides=(1,),
                                    padding=[(k - 1, 0)],
                                    dimension_numbers=('NWC', 'WIO', 'NWC'),
                                    feature_group_count=c)


def head_rmsnorm(h, g):
    H, D = h.shape[-2:]
    y = h * lax.rsqrt(jnp.mean(h * h, axis=-1, keepdims=True) + EPS)
    return y * g.reshape(H, D).astype(jnp.float32)


def mlstm_chunkwise(q, k, v, i_pre, f_pre):
    B, T, H, D = q.shape
    L = ML_CHUNK
    nc = T // L
    f32 = jnp.float32

    def to_chunks(a):
        return a.astype(f32).reshape(B, nc, L, H, D).transpose(0, 3, 1, 2, 4)

    q = to_chunks(q) * D ** -0.5
    k = to_chunks(k)
    v = to_chunks(v)
    log_i = i_pre.astype(f32).reshape(B, nc, L, H).transpose(0, 3, 1, 2)
    log_f = jax.nn.log_sigmoid(f_pre.astype(f32)).reshape(B, nc, L, H).transpose(0, 3, 1, 2)
    b = jnp.cumsum(log_f, axis=-1)
    g = b[..., -1]
    causal = jnp.tril(jnp.ones((L, L), dtype=bool))
    d_log = jnp.where(causal, b[..., :, None] - b[..., None, :] + log_i[..., None, :], -jnp.inf)

    w_end = g[..., None] - b + log_i
    m_loc = jnp.max(w_end, axis=-1)
    e = jnp.exp(w_end - m_loc[..., None])
    c_loc = jnp.einsum('bhcl,bhcld,bhcle->bhcde', e, v, k)
    n_loc = jnp.einsum('bhcl,bhcle->bhce', e, k)

    def step(carry, xs):
        c, n, m = carry
        cl, nl, ml, gc = xs
        m_new = jnp.maximum(gc + m, ml)
        a = jnp.exp(gc + m - m_new)
        s = jnp.exp(ml - m_new)
        c_new = a[..., None, None] * c + s[..., None, None] * cl
        n_new = a[..., None] * n + s[..., None] * nl
        return (c_new, n_new, m_new), (c, n, m)

    init = (jnp.zeros((B, H, D, D), f32), jnp.zeros((B, H, D), f32), jnp.zeros((B, H), f32))
    xs = (c_loc.transpose(2, 0, 1, 3, 4), n_loc.transpose(2, 0, 1, 3),
          m_loc.transpose(2, 0, 1), g.transpose(2, 0, 1))
    _, (c_prev, n_prev, m_prev) = lax.scan(step, init, xs)
    c_prev = c_prev.transpose(1, 2, 0, 3, 4)
    n_prev = n_prev.transpose(1, 2, 0, 3)
    m_prev = m_prev.transpose(1, 2, 0)

    m_inter = b + m_prev[..., None]
    m_t = jnp.maximum(m_inter, jnp.max(d_log, axis=-1))
    s = jnp.einsum('bhcld,bhcsd->bhcls', q, k) * jnp.exp(d_log - m_t[..., None])
    r = jnp.exp(m_inter - m_t)
    num = jnp.einsum('bhcls,bhcsd->bhcld', s, v) + r[..., None] * jnp.einsum('bhcde,bhcle->bhcld', c_prev, q)
    den = jnp.sum(s, axis=-1) + r * jnp.einsum('bhce,bhcle->bhcl', n_prev, q)
    h = num / jnp.maximum(jnp.abs(den), jnp.exp(-m_t))[..., None]
    return h.transpose(0, 2, 3, 1, 4).reshape(B, T, H, D)


def compress_blocks(x, pe, w1, b1, w2):
    B, T, G, Dh = x.shape
    n_cmp = (T - CMP_BLOCK) // CMP_STRIDE + 1
    idx = jnp.arange(n_cmp)[:, None] * CMP_STRIDE + jnp.arange(CMP_BLOCK)[None, :]
    blk = x[:, idx] + pe[:, None, :]
    flat = blk.transpose(0, 1, 3, 2, 4).reshape(B, n_cmp, G, CMP_BLOCK * Dh)
    return jax.nn.silu(flat @ w1 + b1) @ w2


def nsa_compressed(q, kc, vc):
    T = q.shape[1]
    n_cmp = kc.shape[1]
    s = jnp.einsum('btghd,bngd->bghtn', q, kc.astype(jnp.float32))
    cmp_end = jnp.arange(n_cmp) * CMP_STRIDE + CMP_BLOCK - 1
    valid = cmp_end[None, :] <= jnp.arange(T)[:, None]
    p = jax.nn.softmax(jnp.where(valid, s, NEG), axis=-1)
    p = jnp.where(valid, p, 0.0)
    o = jnp.einsum('bghtn,bngd->btghd', p, vc.astype(jnp.float32))
    return o, p


def select_blocks(p_cmp, T):
    n_cmp = p_cmp.shape[-1]
    nslc = T // SLC_BLOCK
    c0 = jnp.arange(n_cmp)[:, None] * CMP_STRIDE
    s0 = jnp.arange(nslc)[None, :] * SLC_BLOCK
    overlap = jnp.clip(jnp.minimum(c0 + CMP_BLOCK, s0 + SLC_BLOCK) - jnp.maximum(c0, s0), 0, None)
    overlap = overlap.astype(jnp.float32) / CMP_BLOCK
    imp = jnp.einsum('bghtn,ns->bgts', p_cmp, overlap)
    t = jnp.arange(T)[:, None]
    blk = jnp.arange(nslc)[None, :]
    cur = t // SLC_BLOCK
    visible = blk * SLC_BLOCK <= t
    forced = (blk == 0) | (blk == cur) | (blk == cur - 1)
    score = jnp.where(forced, FORCE, jnp.where(visible, imp, NEG))
    _, idx = lax.top_k(score, min(SLC_TOPN, nslc))
    return idx


def nsa_selected(q, k, v, idx):
    B, T, G, HPG, Dh = q.shape
    nslc = T // SLC_BLOCK
    nqb = T // Q_BLOCK
    n_sel = idx.shape[-1]
    kb = k.astype(jnp.float32).reshape(B, nslc, SLC_BLOCK, G, Dh).transpose(0, 3, 1, 2, 4)
    vb = v.astype(jnp.float32).reshape(B, nslc, SLC_BLOCK, G, Dh).transpose(0, 3, 1, 2, 4)
    qb = q.reshape(B, nqb, Q_BLOCK, G, HPG, Dh)
    ib = idx.reshape(B, G, nqb, Q_BLOCK, n_sel).transpose(0, 2, 1, 3, 4)
    t0s = jnp.arange(nqb) * Q_BLOCK

    def per_batch(args):
        q_b, k_b, v_b, i_b = args

        def per_qblock(a):
            qq, ii, t0 = a
            ksel = jax.vmap(lambda kg, ig: kg[ig])(k_b, ii)
            vsel = jax.vmap(lambda vg, ig: vg[ig])(v_b, ii)
            s = jnp.einsum('qghd,gqnld->gqhnl', qq, ksel)
            pos = ii[..., None] * SLC_BLOCK + jnp.arange(SLC_BLOCK)
            tq = t0 + jnp.arange(Q_BLOCK)
            valid = pos <= tq[None, :, None, None]
            s = jnp.where(valid[:, :, None], s, NEG)
            p = jax.nn.softmax(s.reshape(G, Q_BLOCK, HPG, n_sel * SLC_BLOCK), axis=-1).reshape(s.shape)
            return jnp.einsum('gqhnl,gqnld->qghd', p, vsel)

        return lax.map(per_qblock, (q_b, i_b, t0s))

    o = lax.map(per_batch, (qb, kb, vb, ib))
    return o.reshape(B, T, G, HPG, Dh)


def nsa_window(q, k, v):
    B, T, G, HPG, Dh = q.shape
    nqb = T // Q_BLOCK
    span = WINDOW + Q_BLOCK
    kp = jnp.pad(k.astype(jnp.float32), ((0, 0), (WINDOW, 0), (0, 0), (0, 0)))
    vp = jnp.pad(v.astype(jnp.float32), ((0, 0), (WINDOW, 0), (0, 0), (0, 0)))
    qb = q.reshape(B, nqb, Q_BLOCK, G, HPG, Dh).swapaxes(0, 1)
    t0s = jnp.arange(nqb) * Q_BLOCK

    def per_qblock(a):
        qq, t0 = a
        kk = lax.dynamic_slice_in_dim(kp, t0, span, axis=1)
        vv = lax.dynamic_slice_in_dim(vp, t0, span, axis=1)
        s = jnp.einsum('bqghd,bkgd->bghqk', qq, kk)
        kpos = t0 - WINDOW + jnp.arange(span)
        tq = t0 + jnp.arange(Q_BLOCK)
        valid = (kpos[None, :] <= tq[:, None]) & (kpos[None, :] > tq[:, None] - WINDOW) & (kpos[None, :] >= 0)
        p = jax.nn.softmax(jnp.where(valid, s, NEG), axis=-1)
        return jnp.einsum('bghqk,bkgd->bqghd', p, vv)

    o = lax.map(per_qblock, (qb, t0s))
    return o.swapaxes(0, 1).reshape(B, T, G, HPG, Dh)


def native_sparse_attention(q, kc_tok, vc_tok, k_slc, v_slc, k_win, v_win, gate_pre,
                            k_pe, k_w1, k_b1, k_w2, v_pe, v_w1, v_b1, v_w2):
    B, T, _ = q.shape
    G, HPG, Dh = NSA_KV_HEADS, NSA_HPG, NSA_DH
    qf = q.astype(jnp.float32).reshape(B, T, G, HPG, Dh) * Dh ** -0.5

    def kv(a):
        return a.reshape(B, T, G, Dh)

    kc = compress_blocks(kv(kc_tok), k_pe, k_w1, k_b1, k_w2)
    vc = compress_blocks(kv(vc_tok), v_pe, v_w1, v_b1, v_w2)
    o_cmp, p_cmp = nsa_compressed(qf, kc, vc)
    idx = select_blocks(p_cmp, T)
    o_slc = nsa_selected(qf, kv(k_slc), kv(v_slc), idx)
    o_win = nsa_window(qf, kv(k_win), kv(v_win))
    gates = jax.nn.sigmoid(gate_pre.astype(jnp.float32)).reshape(B, T, G, HPG, N_BRANCH)
    o = gates[..., 0:1] * o_cmp + gates[..., 1:2] * o_slc + gates[..., 2:3] * o_win
    return o.reshape(B, T, NSA_WIDTH).astype(q.dtype)


def hybrid_mixer(h, w_in, conv_w, ml_b_i, ml_b_f, ml_gn,
                 k_pe, k_w1, k_b1, k_w2, v_pe, v_w1, v_b1, v_w2, w_out):
    B, T, _ = h.shape
    proj = h @ w_in
    sizes = [ML_WIDTH] * 4 + [ML_HEADS] * 2 + [NSA_WIDTH] + [NSA_KV_WIDTH] * 6 + [NSA_HEADS * N_BRANCH]
    offs = np.cumsum(sizes)[:-1].tolist()
    mq, mk, mv, mo, mi, mf, nq, kc, vc, ks, vs, kw, vw, ng = jnp.split(proj, offs, axis=-1)

    qk = jax.nn.silu(causal_conv(jnp.concatenate([mq, mk], axis=-1), conv_w))
    mq, mk = jnp.split(qk, 2, axis=-1)

    def heads(a):
        return a.reshape(B, T, ML_HEADS, ML_DH)

    hm = mlstm_chunkwise(heads(mq), heads(mk), heads(mv), mi + ml_b_i, mf + ml_b_f)
    hm = head_rmsnorm(hm, ml_gn) * jax.nn.sigmoid(heads(mo).astype(jnp.float32))
    hm = hm.reshape(B, T, ML_WIDTH).astype(h.dtype)

    hn = native_sparse_attention(nq, kc, vc, ks, vs, kw, vw, ng,
                                 k_pe, k_w1, k_b1, k_w2, v_pe, v_w1, v_b1, v_w2)
    return jnp.concatenate([hm, hn], axis=-1) @ w_out


def setup_inputs(seed: int = 0) -> dict:
    key = jax.random.key(seed)
    ks = jax.random.split(key, 32)
    f32 = jnp.float32

    def nrm(k, shape, fan_in):
        return jax.random.normal(k, shape, f32) * fan_in ** -0.5

    def gain(k, shape):
        return 1.0 + 0.02 * jax.random.normal(k, shape, f32)

    def small(k, shape, scale):
        return scale * jax.random.normal(k, shape, f32)

    L = DEPTH
    fb = jnp.linspace(3.0, 6.0, ML_HEADS, dtype=f32)[None, :] + small(ks[9], (L, ML_HEADS), 0.1)
    return {
        'x': jax.random.normal(ks[0], (BATCH, SEQ, D_MODEL), f32),
        'ffn1_norm': gain(ks[1], (L, D_MODEL)),
        'ffn1_w1': nrm(ks[2], (L, D_MODEL, D_FF), D_MODEL),
        'ffn1_w3': nrm(ks[3], (L, D_MODEL, D_FF), D_MODEL),
        'ffn1_w2': nrm(ks[4], (L, D_FF, D_MODEL), D_FF),
        'mix_norm': gain(ks[5], (L, D_MODEL)),
        'w_in': nrm(ks[6], (L, D_MODEL, D_IN), D_MODEL),
        'conv_w': nrm(ks[7], (L, CONV_K, 2 * ML_WIDTH), CONV_K),
        'ml_b_i': small(ks[8], (L, ML_HEADS), 0.1),
        'ml_b_f': fb,
        'ml_gn': gain(ks[10], (L, ML_WIDTH)),
        'cmp_k_pe': small(ks[11], (L, CMP_BLOCK, NSA_DH), 0.02),
        'cmp_k_w1': nrm(ks[12], (L, CMP_BLOCK * NSA_DH, CMP_HIDDEN), CMP_BLOCK * NSA_DH),
        'cmp_k_b1': small(ks[13], (L, CMP_HIDDEN), 0.02),
        'cmp_k_w2': nrm(ks[14], (L, CMP_HIDDEN, NSA_DH), CMP_HIDDEN),
        'cmp_v_pe': small(ks[15], (L, CMP_BLOCK, NSA_DH), 0.02),
        'cmp_v_w1': nrm(ks[16], (L, CMP_BLOCK * NSA_DH, CMP_HIDDEN), CMP_BLOCK * NSA_DH),
        'cmp_v_b1': small(ks[17], (L, CMP_HIDDEN), 0.02),
        'cmp_v_w2': nrm(ks[18], (L, CMP_HIDDEN, NSA_DH), CMP_HIDDEN),
        'w_out': nrm(ks[19], (L, D_MIX, D_MODEL), D_MIX),
        'ffn2_norm': gain(ks[20], (L, D_MODEL)),
        'ffn2_w1': nrm(ks[21], (L, D_MODEL, D_FF), D_MODEL),
        'ffn2_w3': nrm(ks[22], (L, D_MODEL, D_FF), D_MODEL),
        'ffn2_w2': nrm(ks[23], (L, D_FF, D_MODEL), D_FF),
        'final_norm': gain(ks[24], (D_MODEL,)),
    }


def reference(x, ffn1_norm, ffn1_w1, ffn1_w3, ffn1_w2, mix_norm, w_in, conv_w, ml_b_i, ml_b_f,
              ml_gn, cmp_k_pe, cmp_k_w1, cmp_k_b1, cmp_k_w2, cmp_v_pe, cmp_v_w1, cmp_v_b1,
              cmp_v_w2, w_out, ffn2_norm, ffn2_w1, ffn2_w3, ffn2_w2, final_norm):
    for l in range(DEPTH):
        x = x + 0.5 * swiglu(rmsnorm(x, ffn1_norm[l]), ffn1_w1[l], ffn1_w3[l], ffn1_w2[l])
        h = rmsnorm(x, mix_norm[l])
        x = x + hybrid_mixer(h, w_in[l], conv_w[l], ml_b_i[l], ml_b_f[l], ml_gn[l],
                             cmp_k_pe[l], cmp_k_w1[l], cmp_k_b1[l], cmp_k_w2[l],
                             cmp_v_pe[l], cmp_v_w1[l], cmp_v_b1[l], cmp_v_w2[l], w_out[l])
        x = x + 0.5 * swiglu(rmsnorm(x, ffn2_norm[l]), ffn2_w1[l], ffn2_w3[l], ffn2_w2[l])
    return rmsnorm(x, final_norm)
```

```cpp
#include <hip/hip_runtime.h>
#include <hip/hip_cooperative_groups.h>
#include <cstdio>
#include <cstdint>
namespace cg = cooperative_groups;

#ifndef ONE_LAUNCH
#define ONE_LAUNCH 1
#endif

#define LAS __attribute__((address_space(3)))
typedef unsigned short bf16_t;
typedef short bf16x8 __attribute__((ext_vector_type(8)));
typedef short bf16x4 __attribute__((ext_vector_type(4)));
typedef float f32x4 __attribute__((ext_vector_type(4)));
typedef unsigned u32x4 __attribute__((ext_vector_type(4)));
typedef unsigned u32x2 __attribute__((ext_vector_type(2)));

constexpr int MTOK = 32768, DM = 1024, FF = 2816, TSEQ = 2048, NB = 16;
constexpr int LDP = 3584;
constexpr int C_MQ = 0, C_MK = 512, C_MV = 1024, C_MO = 1536, C_NQ = 2048, C_KC = 2560, C_VC = 2688, C_KS = 2816, C_VS = 2944, C_KW = 3072, C_VW = 3200, C_GI = 3328, C_GF = 3332, C_NG = 3336;
constexpr float EPS = 1e-6f;

__device__ __forceinline__ bf16_t f2bf(float f) { __bf16 b = (__bf16)f; return __builtin_bit_cast(unsigned short, b); }
__device__ __forceinline__ float bf2f(bf16_t b) { return __uint_as_float(((unsigned)b) << 16); }
typedef __bf16 bf2_t __attribute__((ext_vector_type(2)));
typedef float f2_t __attribute__((ext_vector_type(2)));
__device__ __forceinline__ unsigned pk2(float lo, float hi) { const f2_t v = {lo, hi}; const bf2_t b = __builtin_convertvector(v, bf2_t); return __builtin_bit_cast(unsigned, b); }
__device__ __forceinline__ float frcp(float x) { return __builtin_amdgcn_rcpf(x); }
__device__ __forceinline__ float fexp(float x) { return __builtin_amdgcn_exp2f(x * 1.4426950408889634f); }
__device__ __forceinline__ float sigmoidf_(float x) { return frcp(1.0f + __builtin_amdgcn_exp2f(x * -1.4426950408889634f)); }
__device__ __forceinline__ int otid() { int t = threadIdx.x; asm volatile("" : "+v"(t)); return t; }
#define LDS_BAR() asm volatile("s_waitcnt lgkmcnt(0)\n\ts_barrier" ::: "memory")
#define MFMA16(a, b, c) __builtin_amdgcn_mfma_f32_16x16x32_bf16((a), (b), (c), 0, 0, 0)

struct P {
    const float *x, *f1n, *f1w1, *f1w3, *f1w2, *mixn, *win, *convw, *mlbi, *mlbf, *mlgn;
    const float *kpe, *kw1, *kb1, *kw2, *vpe, *vw1, *vb1, *vw2, *wout, *f2n, *f2w1, *f2w3, *f2w2, *fnorm;
    float* out;
    bf16_t *Wup1, *Wdn1, *Wup2, *Wdn2, *Wint, *Woutt, *Wc1t;
    bf16_t *xb;
    bf16_t *big;
    bf16_t *A2;
    float *ssq;
    float *UV;
    float *b1f;
    bf16_t *KCb;
    bf16_t *qkc;
    unsigned *kmx;
    float *gat;
    unsigned *bar;
};

namespace pg8 {
constexpr int BM = 256, BK = 64, HALF = 128, HTB = HALF * BK * 2, STAGE_BYTES = 8 * HTB, NXCD = 8, WGM = 8;
__host__ __device__ __forceinline__ int lds_byte(int r, int c) { const int st = (r >> 4) * 2 + (c >> 5), rr = r & 15, cc = c & 31, ob = rr * 64 + cc * 2; return st * 1024 + (ob ^ (((ob >> 9) & 1) << 5)); }
__host__ __device__ __forceinline__ void stage_rc(int b, int& R, int& C) { const int st = b / 1024, sb = b % 1024, swz = sb ^ (((sb >> 9) & 1) << 5); R = (st >> 1) * 16 + swz / 64; C = (st & 1) * 32 + (swz % 64) / 2; }
__host__ __device__ __forceinline__ int perm32(int rho) { const int n = rho >> 4, i = rho & 15; return 8 * (i >> 2) + 4 * n + (i & 3); }

struct Unit { int pm, pn, z; const char* a; const char* b; };
struct Dims { int K, lda, kstepA; };

struct Order {
    int nM, nN, nZ, G, c;
    const char* A; const char* Bt; size_t a_tile, b_tile, az0, az1, bz1;
    __device__ bool next(int i, Unit& u) const {
        const long L = (long)i * G + c; const int per = nM * nN;
        if (L >= (long)per * nZ) return false;
        int z = (int)(L / per); int wgid = (int)(L % per);
        { const int nwg = per, q = nwg / NXCD, r = nwg % NXCD, xcd = wgid % NXCD, off = wgid / NXCD; wgid = (xcd < r ? xcd * (q + 1) : r * (q + 1) + (xcd - r) * q) + off; }
        const int nig = WGM * nN, gid = wgid / nig, fm = gid * WGM, gsz = (nM - fm) < WGM ? (nM - fm) : WGM;
        u.pm = fm + ((wgid % nig) % gsz); u.pn = (wgid % nig) / gsz; u.z = z;
        u.a = A + (size_t)(z & 1) * az0 + (size_t)(z >> 1) * az1 + (size_t)u.pm * a_tile;
        u.b = Bt + (size_t)(z >> 1) * bz1 + (size_t)u.pn * b_tile;
        return true;
    }
};

template <class Epi, bool TOUCH = false>
__device__ __forceinline__ void gemm_phase(LAS unsigned char* lds, const Dims g, const Order& S, const Epi& E) {
    const int tid = otid(), wid = __builtin_amdgcn_readfirstlane(tid >> 6), lane = tid & 63, wr = wid >> 2, wc = wid & 3, fr = lane & 15, fq = lane >> 4;
    const int K = g.K, nt = K / BK;
    unsigned voffA[2], voffB[2];
#pragma unroll
    for (int i = 0; i < 2; ++i) { int R, C; stage_rc(tid * 16 + i * 8192, R, C); const int Rb = Epi::PERM ? ((R & ~31) + perm32(R & 31)) : R;
        voffA[i] = (unsigned)(R * g.lda + C) * 2u; voffB[i] = (unsigned)(Rb * K + C) * 2u; }
    const size_t kstepA = (size_t)g.kstepA * 2, kstepB = (size_t)(BK * 2);
    const size_t hstepA = (size_t)HALF * g.lda * 2, hstepB = (size_t)HALF * K * 2;
    const unsigned ldsw = (unsigned)wid * 1024u;
    const int aoff = lds_byte(wr * 64 + fr, fq * 8), boff = lds_byte(wc * 32 + fr, fq * 8);
#define PG8_SA(b, h) (((b) * 2 + (h)) * HTB)
#define PG8_SB(b, h) ((4 + (b) * 2 + (h)) * HTB)
#define PG8_STAGE(bufoff, gbase, voff) do { _Pragma("unroll") for (int _i = 0; _i < 2; ++_i) \
        __builtin_amdgcn_global_load_lds((const unsigned*)((const char*)(gbase) + (voff)[_i]), (LAS unsigned*)(lds + (bufoff) + ldsw + _i * 8192), 16, 0, 0); } while (0)
#define PG8_LDA(dst, b, h) do { _Pragma("unroll") for (int m = 0; m < 4; ++m) _Pragma("unroll") for (int k = 0; k < 2; ++k) dst[m][k] = *(const LAS bf16x8*)(lds + PG8_SA(b, h) + aoff + m * 2048 + k * 1024); } while (0)
#define PG8_LDB(dst, b, h) do { _Pragma("unroll") for (int n = 0; n < 2; ++n) _Pragma("unroll") for (int k = 0; k < 2; ++k) dst[n][k] = *(const LAS bf16x8*)(lds + PG8_SB(b, h) + boff + n * 2048 + k * 1024); } while (0)
#define PG8_MMA(ai, bj, At, Bt) do { __builtin_amdgcn_s_setprio(1); _Pragma("unroll") for (int m = 0; m < 4; ++m) _Pragma("unroll") for (int n = 0; n < 2; ++n) _Pragma("unroll") for (int k = 0; k < 2; ++k) \
        acc[ai][bj][m][n] = __builtin_amdgcn_mfma_f32_16x16x32_bf16(Bt[n][k], At[m][k], acc[ai][bj][m][n], 0, 0, 0); __builtin_amdgcn_s_setprio(0); } while (0)
#define PG8_WAIT_V(n) asm volatile("s_waitcnt vmcnt(" #n ")" ::: "memory")
#define PG8_WAIT_L(n) asm volatile("s_waitcnt lgkmcnt(" #n ")" ::: "memory")
#define PG8_BAR __builtin_amdgcn_s_barrier()
#define PG8_SCHED __builtin_amdgcn_sched_barrier(0)
    constexpr int TOUCH_D = 6;
#define PG8_TOUCH(reg, tt) do { const int _tt = (tt); const char* _sb = (_tt < nt) ? cA + (size_t)_tt * kstepA : (has_next ? nA + (size_t)(_tt - nt) * kstepA : cA); \
        const char* _p = _sb + (cur.pn & 3) * 8192 + (wid * 8 + (lane >> 3)) * 128; asm volatile("global_load_dword %0, %1, off" : "=v"(reg) : "v"(_p) : "memory"); } while (0)
    unsigned tchA = 0u, tchB = 0u;
    Unit cur, nxt; int ui = 0;
    if (!S.next(0, cur)) return;
    f32x4 acc[2][2][4][2];
#pragma unroll
    for (int a = 0; a < 2; ++a)
#pragma unroll
        for (int b = 0; b < 2; ++b)
#pragma unroll
            for (int m = 0; m < 4; ++m)
#pragma unroll
                for (int n = 0; n < 2; ++n) acc[a][b][m][n] = (f32x4){0.f, 0.f, 0.f, 0.f};
    bf16x8 At[4][2], B0[2][2], B1[2][2];
    const char* cA = cur.a; const char* cB = cur.b;
    PG8_STAGE(PG8_SB(0, 0), cB, voffB); PG8_STAGE(PG8_SB(0, 1), cB + hstepB, voffB); PG8_STAGE(PG8_SA(0, 0), cA, voffA); PG8_STAGE(PG8_SA(0, 1), cA + hstepA, voffA);
    if (wr == 1) PG8_BAR;
    PG8_WAIT_V(2); PG8_BAR;
    PG8_STAGE(PG8_SB(1, 0), cB + kstepB, voffB); PG8_STAGE(PG8_SA(1, 0), cA + kstepA, voffA); PG8_STAGE(PG8_SB(1, 1), cB + hstepB + kstepB, voffB);
    PG8_WAIT_V(6); PG8_BAR;
    for (;;) {
        const bool has_next = S.next(ui + 1, nxt);
        const char* nA = has_next ? nxt.a : cA; const char* nB = has_next ? nxt.b : cB;
        for (int t = 0; t < nt; t += 2) {
            const bool last = (t == nt - 2);
            const char* a1 = cA + (size_t)(t + 1) * kstepA;
            const char* a2 = last ? nA : cA + (size_t)(t + 2) * kstepA; const char* b2 = last ? nB : cB + (size_t)(t + 2) * kstepB;
            const char* a3 = a2 + kstepA; const char* b3 = b2 + kstepB;
            PG8_LDB(B0, 0, 0); PG8_LDB(B1, 0, 1); PG8_SCHED; PG8_LDA(At, 0, 0); PG8_STAGE(PG8_SA(1, 1), a1 + hstepA, voffA);
            if constexpr (TOUCH) { PG8_TOUCH(tchA, t + TOUCH_D); PG8_WAIT_V(9); asm volatile("" :: "v"(tchB)); } else PG8_WAIT_V(8);
            PG8_WAIT_L(0); PG8_BAR; PG8_MMA(0, 0, At, B0); PG8_MMA(0, 1, At, B1); PG8_BAR; PG8_SCHED;
            PG8_LDA(At, 0, 1); PG8_STAGE(PG8_SB(0, 0), b2, voffB); PG8_STAGE(PG8_SB(0, 1), b2 + hstepB, voffB); PG8_STAGE(PG8_SA(0, 0), a2, voffA);
            if constexpr (TOUCH) PG8_WAIT_V(9); else PG8_WAIT_V(8);
            PG8_WAIT_L(0); PG8_BAR; PG8_MMA(1, 0, At, B0); PG8_MMA(1, 1, At, B1); PG8_BAR; PG8_SCHED;
            PG8_LDB(B0, 1, 0); PG8_LDB(B1, 1, 1); PG8_SCHED; PG8_LDA(At, 1, 0); PG8_STAGE(PG8_SA(0, 1), a2 + hstepA, voffA);
            if constexpr (TOUCH) { PG8_TOUCH(tchB, t + 1 + TOUCH_D); PG8_WAIT_V(9); asm volatile("" :: "v"(tchA)); } else PG8_WAIT_V(8);
            PG8_WAIT_L(0); PG8_BAR; PG8_MMA(0, 0, At, B0); PG8_MMA(0, 1, At, B1); PG8_BAR; PG8_SCHED;
            PG8_LDA(At, 1, 1); PG8_STAGE(PG8_SB(1, 0), b3, voffB); PG8_STAGE(PG8_SB(1, 1), b3 + hstepB, voffB); PG8_STAGE(PG8_SA(1, 0), a3, voffA);
            if constexpr (TOUCH) PG8_WAIT_V(9); else PG8_WAIT_V(8);
            PG8_WAIT_L(0); PG8_BAR; PG8_MMA(1, 0, At, B0); PG8_MMA(1, 1, At, B1); PG8_BAR; PG8_SCHED;
        }
        if constexpr (TOUCH) { PG8_WAIT_V(6); asm volatile("" :: "v"(tchA), "v"(tchB)); }
        if (wr == 0) PG8_BAR;
        E(acc, cur, wr, wc, fr, fq);
        if (!has_next) break;
#pragma unroll
        for (int a = 0; a < 2; ++a)
#pragma unroll
            for (int b = 0; b < 2; ++b)
#pragma unroll
                for (int m = 0; m < 4; ++m)
#pragma unroll
                    for (int n = 0; n < 2; ++n) acc[a][b][m][n] = (f32x4){0.f, 0.f, 0.f, 0.f};
        cur = nxt; cA = nA; cB = nB; ++ui;
        if (wr == 1) PG8_BAR;
    }
    PG8_WAIT_V(0);
    PG8_BAR;
#undef PG8_SA
#undef PG8_SB
#undef PG8_STAGE
#undef PG8_LDA
#undef PG8_LDB
#undef PG8_MMA
#undef PG8_WAIT_V
#undef PG8_WAIT_L
#undef PG8_BAR
#undef PG8_SCHED
#undef PG8_TOUCH
}
}

struct EpiUp {
    static constexpr bool PERM = true;
    bf16_t* H; const float* ssq;
    __device__ __forceinline__ void operator()(const f32x4 (&acc)[2][2][4][2], const pg8::Unit& u, int wr, int wc, int fr, int fq) const {
#pragma unroll
        for (int ai = 0; ai < 2; ++ai)
#pragma unroll
            for (int m = 0; m < 4; ++m) {
                const int row = u.pm * 256 + ai * 128 + wr * 64 + m * 16 + fr;
                const float rs = rsqrtf(ssq[row] * (1.0f / DM) + EPS);
                float hv[8];
#pragma unroll
                for (int n = 0; n < 2; ++n)
#pragma unroll
                    for (int i = 0; i < 4; ++i) { const float a = acc[ai][0][m][n][i] * rs, b = acc[ai][1][m][n][i] * rs; hv[n * 4 + i] = a * sigmoidf_(a) * b; }
                u32x4 w; w.x = pk2(hv[0], hv[1]); w.y = pk2(hv[2], hv[3]); w.z = pk2(hv[4], hv[5]); w.w = pk2(hv[6], hv[7]);
                { const int r = ai * 128 + wr * 64 + m * 16 + fr, kt = 2 * u.pn + (wc >> 1), cc = (wc & 1) * 32 + fq * 8;
                  __builtin_nontemporal_store(w, (u32x4*)(H + ((size_t)(u.pm * 44 + kt) * 256 + r) * 64 + cc)); }
            }
    }
};
struct EpiRes {
    static constexpr bool PERM = true;
    const float* resid_f; bf16_t* xb; float* ssq; float scale;
    __device__ __forceinline__ void operator()(const f32x4 (&acc)[2][2][4][2], const pg8::Unit& u, int wr, int wc, int fr, int fq) const {
#pragma unroll
        for (int ai = 0; ai < 2; ++ai) {
            u32x4 r[4][2];
#pragma unroll
            for (int m = 0; m < 4; ++m) { const size_t off = (size_t)(u.pm * 256 + ai * 128 + wr * 64 + m * 16 + fr) * DM + u.pn * 256 + wc * 32 + fq * 8;
#pragma unroll
                for (int bj = 0; bj < 2; ++bj) r[m][bj] = *(const u32x4*)(xb + off + bj * 128); }
            float ss[4];
#pragma unroll
            for (int m = 0; m < 4; ++m) { const size_t off = (size_t)(u.pm * 256 + ai * 128 + wr * 64 + m * 16 + fr) * DM + u.pn * 256 + wc * 32 + fq * 8;
                float s = 0.f;
#pragma unroll
                for (int bj = 0; bj < 2; ++bj) {
                    u32x4 w;
#pragma unroll
                    for (int n = 0; n < 2; ++n) { const unsigned bx = r[m][bj][2 * n], by = r[m][bj][2 * n + 1]; f32x4 rv;
                        rv[0] = __uint_as_float(bx << 16); rv[1] = __uint_as_float(bx & 0xffff0000u); rv[2] = __uint_as_float(by << 16); rv[3] = __uint_as_float(by & 0xffff0000u);
                        const f32x4 v = rv + acc[ai][bj][m][n] * scale;
                        w[2 * n] = pk2(v[0], v[1]); w[2 * n + 1] = pk2(v[2], v[3]);
                        s += (v[0] * v[0] + v[1] * v[1]) + (v[2] * v[2] + v[3] * v[3]); }
                    *(u32x4*)(xb + off + bj * 128) = w; }
                s += __shfl_xor(s, 16); s += __shfl_xor(s, 32); ss[m] = s; }
            if (fq == 0) {
#pragma unroll
                for (int m = 0; m < 4; ++m) atomicAdd(ssq + u.pm * 256 + ai * 128 + wr * 64 + m * 16 + fr, ss[m]); }
        }
    }
};
struct EpiProj {
    static constexpr bool PERM = true;
    bf16_t* O; const float* ssq;
    __device__ __forceinline__ void operator()(const f32x4 (&acc)[2][2][4][2], const pg8::Unit& u, int wr, int wc, int fr, int fq) const {
#pragma unroll
        for (int ai = 0; ai < 2; ++ai)
#pragma unroll
            for (int m = 0; m < 4; ++m) {
                const int row = u.pm * 256 + ai * 128 + wr * 64 + m * 16 + fr;
                const float rs = rsqrtf(ssq[row] * (1.0f / DM) + EPS);
#pragma unroll
                for (int bj = 0; bj < 2; ++bj) {
                    const f32x4 v0 = acc[ai][bj][m][0] * rs, v1 = acc[ai][bj][m][1] * rs;
                    u32x4 w; w.x = pk2(v0[0], v0[1]); w.y = pk2(v0[2], v0[3]); w.z = pk2(v1[0], v1[1]); w.w = pk2(v1[2], v1[3]);
                    __builtin_nontemporal_store(w, (u32x4*)(O + (size_t)row * LDP + u.pn * 256 + bj * 128 + wc * 32 + fq * 8));
                }
            }
    }
};
struct EpiUV {
    static constexpr bool PERM = false;
    float* UV;
    __device__ __forceinline__ void operator()(const f32x4 (&acc)[2][2][4][2], const pg8::Unit& u, int wr, int wc, int fr, int fq) const {
#pragma unroll
        for (int ai = 0; ai < 2; ++ai)
#pragma unroll
            for (int m = 0; m < 4; ++m) {
                const int row = u.pm * 256 + ai * 128 + wr * 64 + m * 16 + fr;
                float* rp = UV + ((size_t)u.z * 2048 + row) * 512 + u.pn * 256 + wc * 32 + fq * 4;
#pragma unroll
                for (int bj = 0; bj < 2; ++bj)
#pragma unroll
                    for (int n = 0; n < 2; ++n) *(f32x4*)(rp + bj * 128 + n * 16) = acc[ai][bj][m][n];
            }
    }
};

__device__ __forceinline__ int rowmap(int mode, int j) {
    if (mode == 1) return ((j >> 7) << 8) + (j & 127);
    if (mode == 2) return ((j >> 7) << 8) + 128 + (j & 127);
    if (mode == 3) { if (j < 2048) return j; if (j < 2056) return 3328 + (j - 2048); if (j < 3336) return j - 8; return j; }
    return j;
}
__device__ __forceinline__ void transpose_item(const float* W, int N, int k0, int n0, const float* gain, bf16_t* Bt, int Kdst, int kd0, int rowoff, int mode, LAS float* scr, int lane) {
    const int n4 = (lane & 7) * 4, kr = lane >> 3;
    f32x4 v[8];
#pragma unroll
    for (int i = 0; i < 8; ++i) v[i] = __builtin_nontemporal_load((const f32x4*)(W + (size_t)(k0 + i * 8 + kr) * N + n0 + n4));
    if (gain) {
#pragma unroll
        for (int i = 0; i < 8; ++i) v[i] = v[i] * gain[k0 + i * 8 + kr]; }
#pragma unroll
    for (int i = 0; i < 8; ++i) { LAS float* d = scr + (i * 8 + kr) * 33 + n4; d[0] = v[i][0]; d[1] = v[i][1]; d[2] = v[i][2]; d[3] = v[i][3]; }
    asm volatile("s_waitcnt lgkmcnt(0)" ::: "memory");
    const int c = lane & 7;
#pragma unroll
    for (int j = 0; j < 4; ++j) { const int n = (lane >> 3) + 8 * j; const LAS float* q = scr + (8 * c) * 33 + n;
        u32x4 o; o.x = pk2(q[0], q[33]); o.y = pk2(q[2 * 33], q[3 * 33]); o.z = pk2(q[4 * 33], q[5 * 33]); o.w = pk2(q[6 * 33], q[7 * 33]);
        *(u32x4*)(Bt + (size_t)(rowmap(mode, n0 + n) + rowoff) * Kdst + kd0 + 8 * c) = o; }
    asm volatile("s_waitcnt lgkmcnt(0)" ::: "memory");
}
__device__ __forceinline__ float wave_sum(float v) {
#pragma unroll
    for (int o = 1; o < 64; o <<= 1) v += __shfl_xor(v, o);
    return v;
}
__device__ __forceinline__ void phase_prep_late(const P& p, LAS unsigned char* lds, int widx, int wcnt, int it_lo, int it_hi) {
    const int tid = otid();
    LAS float* scr = (LAS float*)lds + (tid >> 6) * (64 * 33);
    const int lane_ = tid & 63, gw_ = widx * 8 + (tid >> 6), NGW_ = wcnt * 8;
    constexpr int I_UP = 16 * 88, I_DN = 44 * 32, I_OUT = 16 * 32;
    constexpr int NIT = (2 * I_UP + I_DN) + I_OUT;
    if (it_hi > NIT) it_hi = NIT;
    __syncthreads();
    for (int it = it_lo + gw_; it < it_hi; it += NGW_) {
        int r = it;
        if (r < I_UP) { transpose_item(p.f2w1, FF, (r / 88) * 64, (r % 88) * 32, p.f2n, p.Wup2, DM, (r / 88) * 64, 0, 1, scr, lane_); continue; } r -= I_UP;
        if (r < I_UP) { transpose_item(p.f2w3, FF, (r / 88) * 64, (r % 88) * 32, p.f2n, p.Wup2, DM, (r / 88) * 64, 0, 2, scr, lane_); continue; } r -= I_UP;
        if (r < I_DN) { transpose_item(p.f2w2, DM, (r / 32) * 64, (r % 32) * 32, nullptr, p.Wdn2, FF, (r / 32) * 64, 0, 0, scr, lane_); continue; } r -= I_DN;
        transpose_item(p.wout, DM, (r / 32) * 64, (r % 32) * 32, nullptr, p.Woutt, DM, (r / 32) * 64, 0, 0, scr, lane_);
    }
    __syncthreads();
}
__device__ __forceinline__ void phase_prep(const P& p, LAS unsigned char* lds) {
    const int G = gridDim.x, c = blockIdx.x, tid = otid();
    LAS float* scr = (LAS float*)lds + (tid >> 6) * (64 * 33);
    const int lane_ = tid & 63, gw_ = c * 8 + (tid >> 6), NGW_ = G * 8;
    constexpr int I_UP = 16 * 88, I_DN = 44 * 32, I_IN = 16 * 105, I_C = 32 * 8;
    constexpr int NIT = (2 * I_UP + I_DN) + I_IN + 2 * I_C;
    for (int it = gw_; it < NIT; it += NGW_) {
        int r = it;
        if (r < I_UP) { transpose_item(p.f1w1, FF, (r / 88) * 64, (r % 88) * 32, p.f1n, p.Wup1, DM, (r / 88) * 64, 0, 1, scr, lane_); continue; } r -= I_UP;
        if (r < I_UP) { transpose_item(p.f1w3, FF, (r / 88) * 64, (r % 88) * 32, p.f1n, p.Wup1, DM, (r / 88) * 64, 0, 2, scr, lane_); continue; } r -= I_UP;
        if (r < I_DN) { transpose_item(p.f1w2, DM, (r / 32) * 64, (r % 32) * 32, nullptr, p.Wdn1, FF, (r / 32) * 64, 0, 0, scr, lane_); continue; } r -= I_DN;
        if (r < I_IN) { transpose_item(p.win, 3360, (r / 105) * 64, (r % 105) * 32, p.mixn, p.Wint, DM, (r / 105) * 64, 0, 3, scr, lane_); continue; } r -= I_IN;
        { const int which = r / I_C; r %= I_C; const int k0 = (r / 8) * 64, n0 = (r % 8) * 32;
          transpose_item(which ? p.vw1 : p.kw1, 256, k0, n0, nullptr, p.Wc1t + (size_t)which * 512 * 1024, 1024, k0 & 1023, (k0 >> 10) * 256, 0, scr, lane_); }
    }
    { u32x4 z = {0u, 0u, 0u, 0u}; u32x4* dst = (u32x4*)(p.Wint + (size_t)3360 * DM); const int n16 = 224 * DM / 8;
      for (int i = c * 512 + tid; i < n16; i += G * 512) dst[i] = z; }
    for (int i = c * 512 + tid; i < 3 * MTOK; i += G * 512) p.ssq[MTOK + i] = 0.f;
    if (c == 0 && tid < 64) p.kmx[tid] = 0u;
    { const int lane = tid & 63, gw = c * 8 + (tid >> 6), NGW = G * 8;
      for (int row0 = gw; row0 < MTOK; row0 += 4 * NGW) {
          f32x4 v[4][4];
#pragma unroll
          for (int r = 0; r < 4; ++r) { const int row = row0 + r * NGW; if (row < MTOK) { const f32x4* xr = (const f32x4*)(p.x + (size_t)row * DM) + lane;
#pragma unroll
              for (int j = 0; j < 4; ++j) v[r][j] = __builtin_nontemporal_load(xr + 64 * j); } }
#pragma unroll
          for (int r = 0; r < 4; ++r) { const int row = row0 + r * NGW; if (row < MTOK) { u32x2* o = (u32x2*)(p.xb + (size_t)row * DM) + lane; float s = 0.f;
#pragma unroll
              for (int j = 0; j < 4; ++j) { const f32x4 t = v[r][j]; s += (t[0] * t[0] + t[1] * t[1]) + (t[2] * t[2] + t[3] * t[3]); u32x2 w; w.x = pk2(t[0], t[1]); w.y = pk2(t[2], t[3]); o[64 * j] = w; }
              s = wave_sum(s); if (lane == 0) p.ssq[row] = s; } } } }
    if (c < 8) {
        LAS float* scr = (LAS float*)lds;
        __syncthreads();
        const int which = c >> 2, col = (c & 3) * 64 + (tid & 63), part = tid >> 6;
        const float* pe = which ? p.vpe : p.kpe; const float* w1 = which ? p.vw1 : p.kw1; const float* b1 = which ? p.vb1 : p.kb1;
        float s = 0.f;
        for (int k = part * 256; k < part * 256 + 256; ++k) s += pe[k] * w1[(size_t)k * 256 + col];
        scr[part * 64 + (tid & 63)] = s;
        __syncthreads();
        if (tid < 64) { float t = b1[col]; for (int q = 0; q < 8; ++q) t += scr[q * 64 + tid]; p.b1f[which * 256 + col] = t; }
        __syncthreads();
    }
}

__device__ __forceinline__ void phase_cmp2(const P& p, LAS unsigned char* lds) {
    const int tid = otid(), lane = tid & 63, w = tid >> 6;
    LAS bf16_t* w2s = (LAS bf16_t*)lds;
    LAS float* zs = (LAS float*)(lds + 65536) + w * 256;
    const int gw = blockIdx.x * 8 + w, NGW = gridDim.x * 8;
    __syncthreads();
    for (int r0 = gw; r0 < 2 * 4096; r0 += 4 * NGW) {
        float zin[4][4];
#pragma unroll
        for (int i = 0; i < 4; ++i) { const int r = r0 + i * NGW;
            if (r < 2 * 4096) { const int which = r >> 12, n = r & 127, g = (r >> 7) & 1, b = (r >> 8) & 15;
                const float* U = p.UV + ((size_t)(which * 2 + g) * 2048 + b * 128 + (n == 127 ? 126 : n)) * 512;
#pragma unroll
                for (int k = 0; k < 4; ++k) { const int cc = lane + 64 * k; zin[i][k] = U[cc] + U[512 + 256 + cc] + p.b1f[which * 256 + cc]; } } }
        if (r0 == gw) {
            for (int i = tid; i < 2 * 256 * 64 / 4; i += 512) { const f32x4 v = (i < 4096) ? *(const f32x4*)(p.kw2 + 4 * i) : *(const f32x4*)(p.vw2 + 4 * (i - 4096));
                u32x2 o; o.x = pk2(v[0], v[1]); o.y = pk2(v[2], v[3]); *(LAS u32x2*)(w2s + 4 * i) = o; }
            __syncthreads();
        }
#pragma unroll
        for (int i = 0; i < 4; ++i) { const int r = r0 + i * NGW;
            if (r < 2 * 4096) { const int which = r >> 12, n = r & 127;
                bf16_t* dst = p.KCb + (size_t)r * 64;
                if (n == 127) { dst[lane] = 0; }
                else {
#pragma unroll
                    for (int k = 0; k < 4; ++k) { const float z = zin[i][k]; zs[lane + 64 * k] = z * sigmoidf_(z); }
                    asm volatile("s_waitcnt lgkmcnt(0)" ::: "memory");
                    const LAS bf16_t* wm = w2s + which * (256 * 64);
                    float s0 = 0.f, s1 = 0.f, s2 = 0.f, s3 = 0.f;
#pragma unroll 8
                    for (int k = 0; k < 256; k += 4) { const f32x4 z4 = *(const LAS f32x4*)(zs + k);
                        s0 += z4[0] * bf2f(wm[(k + 0) * 64 + lane]); s1 += z4[1] * bf2f(wm[(k + 1) * 64 + lane]); s2 += z4[2] * bf2f(wm[(k + 2) * 64 + lane]); s3 += z4[3] * bf2f(wm[(k + 3) * 64 + lane]); }
                    dst[lane] = f2bf((s0 + s1) + (s2 + s3));
                    asm volatile("s_waitcnt lgkmcnt(0)" ::: "memory");
                } } }
    }
    __syncthreads();
}

__device__ __forceinline__ void phase_conv(const P& p, int widx, int wcnt) {
    const int tid = otid(); const int cg8 = (tid & 127) * 8, seg = tid >> 7;
    const bf16_t* proj = p.big;
    float cw[4][8];
#pragma unroll
    for (int j = 0; j < 4; ++j)
#pragma unroll
        for (int i = 0; i < 8; ++i) cw[j][i] = p.convw[j * 1024 + cg8 + i];
    const float osc = (cg8 < 512) ? 0.08838834764831845f : 1.0f;
    for (int item = widx; item < MTOK / 64; item += wcnt) {
        const int tok0 = item * 64 + seg * 16; const int tin = tok0 & (TSEQ - 1);
        float x0[8], x1[8], x2[8];
#define CV_UNPACK(dst, r) do { _Pragma("unroll") for (int e = 0; e < 4; ++e) { dst[2 * e] = __uint_as_float((r)[e] << 16); dst[2 * e + 1] = __uint_as_float((r)[e] & 0xffff0000u); } } while (0)
        { const u32x4 z = {0u, 0u, 0u, 0u};
          const u32x4 r0 = (tin >= 3) ? *(const u32x4*)(proj + (size_t)(tok0 - 3) * LDP + cg8) : z;
          const u32x4 r1 = (tin >= 2) ? *(const u32x4*)(proj + (size_t)(tok0 - 2) * LDP + cg8) : z;
          const u32x4 r2 = (tin >= 1) ? *(const u32x4*)(proj + (size_t)(tok0 - 1) * LDP + cg8) : z;
          CV_UNPACK(x0, r0); CV_UNPACK(x1, r1); CV_UNPACK(x2, r2); }
        u32x4 rr[16];
#pragma unroll
        for (int t = 0; t < 16; ++t) rr[t] = __builtin_nontemporal_load((const u32x4*)(proj + (size_t)(tok0 + t) * LDP + cg8));
#pragma unroll
        for (int t = 0; t < 16; ++t) {
            float x3[8], y[8]; CV_UNPACK(x3, rr[t]);
#pragma unroll
            for (int ch = 0; ch < 8; ++ch) {
                const float v = (cw[0][ch] * x0[ch] + cw[1][ch] * x1[ch]) + (cw[2][ch] * x2[ch] + cw[3][ch] * x3[ch]);
                y[ch] = v * sigmoidf_(v) * osc; x0[ch] = x1[ch]; x1[ch] = x2[ch]; x2[ch] = x3[ch]; }
            u32x4 o; o.x = pk2(y[0], y[1]); o.y = pk2(y[2], y[3]); o.z = pk2(y[4], y[5]); o.w = pk2(y[6], y[7]);
            *(u32x4*)(p.qkc + (size_t)(tok0 + t) * DM + cg8) = o;
        }
#undef CV_UNPACK
    }
}

__device__ __forceinline__ void phase_gates(const P& p, int widx, int wcnt) {
    const int tid = otid(), lane = tid & 63; const int gw = widx * 8 + (tid >> 6), NGW = wcnt * 8;
    const bf16_t* proj = p.big;
    for (int task = gw; task < 16 * 4 * 32; task += NGW) {
        const int c = task & 31, h = (task >> 5) & 3, b = task >> 7;
        const size_t tok = (size_t)b * TSEQ + c * 64 + lane;
        const float fpre = bf2f(proj[tok * LDP + C_GF + h]) + p.mlbf[h];
        const float li = bf2f(proj[tok * LDP + C_GI + h]) + p.mlbi[h];
        const float lf = fminf(fpre, 0.f) - log1pf(fexp(-fabsf(fpre)));
        float bb = lf;
#pragma unroll
        for (int o = 1; o < 64; o <<= 1) { const float t = __shfl_up(bb, o); if (lane >= o) bb += t; }
        const float u = li - bb; float pmx = u;
#pragma unroll
        for (int o = 1; o < 64; o <<= 1) { const float t = __shfl_up(pmx, o); if (lane >= o) pmx = fmaxf(pmx, t); }
        *(f32x4*)(p.gat + ((size_t)(b * 4 + h) * TSEQ + c * 64 + lane) * 4) = (f32x4){bb, u, pmx, 0.f};
    }
}

__device__ __forceinline__ void phase_kmax(const P& p, int widx, int wcnt) {
    const int tid = otid(), lane = tid & 63; const int gw = widx * 8 + (tid >> 6), NGW = wcnt * 8;
    const bf16_t* proj = p.big;
    for (int task = gw; task < 64 * 4; task += NGW) {
        const int qd = task & 3, id = task >> 2, br = id & 1, g = (id >> 1) & 1, b = id >> 2;
        const int col = (br ? C_KW : C_KS) + g * 64; float mx = 0.f;
        for (int i = 0; i < 8; ++i) { const size_t tok = (size_t)b * TSEQ + qd * 512 + i * 64 + lane; float s2 = 0.f;
#pragma unroll
            for (int c8 = 0; c8 < 8; ++c8) { const u32x4 kv = *(const u32x4*)(proj + tok * LDP + col + c8 * 8);
#pragma unroll
                for (int e = 0; e < 4; ++e) { const float lo = __uint_as_float(kv[e] << 16), hi = __uint_as_float(kv[e] & 0xffff0000u); s2 += lo * lo + hi * hi; } }
            mx = fmaxf(mx, s2); }
#pragma unroll
        for (int o = 1; o < 64; o <<= 1) mx = fmaxf(mx, __shfl_xor(mx, o));
        if (lane == 0) atomicMax(p.kmx + id, __float_as_uint(mx));
    }
}

__device__ __forceinline__ f32x4 mma_tile(const LAS bf16_t* A, int lda, const LAS bf16_t* Bt, int ldb, int K, f32x4 acc, int lane) {
    const LAS bf16_t* pa = A + (lane & 15) * lda + (lane >> 4) * 8; const LAS bf16_t* pb = Bt + (lane & 15) * ldb + (lane >> 4) * 8;
    for (int k = 0; k < K; k += 32) { const bf16x8 a = *(const LAS bf16x8*)(pa + k); const bf16x8 b = *(const LAS bf16x8*)(pb + k); acc = MFMA16(a, b, acc); }
    return acc;
}
__device__ __forceinline__ void mlstm_unit(const P& p, LAS unsigned char* lds, int unit) {
    const int tid = otid(), lane = tid & 63, w = tid >> 6, q4 = lane >> 4, r16 = lane & 15;
    const int dvs = unit & 3, h = (unit >> 2) & 3, b = unit >> 4;
    LAS bf16_t* Qs = (LAS bf16_t*)lds;
    LAS bf16_t* Ks = Qs + 64 * 136;
    LAS bf16_t* KTs = Ks + 64 * 136;
    LAS bf16_t* VT0 = KTs + 128 * 72;
    LAS bf16_t* Cs = VT0 + 2 * 48 * 72;
    LAS bf16_t* Ss = Cs + 48 * 136;
    LAS float* gl0 = (LAS float*)(Ss + 64 * 72);
    const bf16_t* proj = p.big;
    __syncthreads();
    for (int i = tid; i < 16 * 72; i += 512) { VT0[32 * 72 + i] = (bf16_t)0x3F80; VT0[48 * 72 + 32 * 72 + i] = (bf16_t)0x3F80; }
    for (int i = tid; i < 48 * 136; i += 512) Cs[i] = 0;
    f32x4 accC[3];
#pragma unroll
    for (int i = 0; i < 3; ++i) accC[i] = (f32x4){0.f, 0.f, 0.f, 0.f};
    float m_prev = 0.f, adec = 1.f;
    const bf16_t* qk = p.qkc;
    const int lt_ = tid & 63, cg16 = (tid >> 6) * 16;
    u32x4 qr[2], kr[2]; u32x2 vraw; f32x4 gv;
#define ML_LOAD(cc) do { const size_t _t = (size_t)(b * TSEQ + (cc) * 64 + lt_); \
        gv = *(const f32x4*)(p.gat + ((size_t)(b * 4 + h) * TSEQ + (cc) * 64 + lt_) * 4); \
        qr[0] = *(const u32x4*)(qk + _t * DM + h * 128 + cg16); qr[1] = *(const u32x4*)(qk + _t * DM + h * 128 + cg16 + 8); \
        kr[0] = *(const u32x4*)(qk + _t * DM + 512 + h * 128 + cg16); kr[1] = *(const u32x4*)(qk + _t * DM + 512 + h * 128 + cg16 + 8); \
        vraw = *(const u32x2*)(proj + _t * LDP + C_MV + h * 128 + dvs * 32 + (tid >> 6) * 4); } while (0)
#define ML_STAGE(cc) do { \
        const float bb = gv[0], u = gv[1], pmx = gv[2]; \
        const float gsum = __int_as_float(__builtin_amdgcn_readlane(__float_as_int(bb), 63)); \
        const float pmx63 = __int_as_float(__builtin_amdgcn_readlane(__float_as_int(pmx), 63)); \
        const float m_inter = bb + m_prev, mt = fmaxf(m_inter, bb + pmx), rr = fexp(m_inter - mt); \
        const float mloc = gsum + pmx63, m_new = fmaxf(gsum + m_prev, mloc); \
        adec = fexp(gsum + m_prev - m_new); \
        const float es = fexp(gsum + u - m_new), c1 = bb - mt, nd = fexp(-mt); \
        m_prev = m_new; \
        LAS float* gl = gl0 + ((cc) & 1) * 256; LAS bf16_t* VTs = VT0 + ((cc) & 1) * (48 * 72); \
        if (w == 0) { gl[lane] = c1; gl[64 + lane] = u; gl[128 + lane] = rr; gl[192 + lane] = nd; } \
        *(LAS u32x4*)(Qs + lt_ * 136 + cg16) = qr[0]; *(LAS u32x4*)(Qs + lt_ * 136 + cg16 + 8) = qr[1]; \
        *(LAS u32x4*)(Ks + lt_ * 136 + cg16) = kr[0]; *(LAS u32x4*)(Ks + lt_ * 136 + cg16 + 8) = kr[1]; \
        _Pragma("unroll") for (int hf = 0; hf < 2; ++hf) \
            _Pragma("unroll") for (int e = 0; e < 4; ++e) { const unsigned wd = kr[hf][e]; const int ch = cg16 + hf * 8 + 2 * e; const int col = lt_ ^ ((((cg16 >> 3) + hf) & 7) << 3); \
                KTs[ch * 72 + col] = f2bf(__uint_as_float(wd << 16) * es); KTs[(ch + 1) * 72 + col] = f2bf(__uint_as_float(wd & 0xffff0000u) * es); } \
        { const int dv4 = (tid >> 6) * 4; \
          VTs[(dv4 + 0) * 72 + lt_] = (bf16_t)(vraw.x & 0xffffu); VTs[(dv4 + 1) * 72 + lt_] = (bf16_t)(vraw.x >> 16); \
          VTs[(dv4 + 2) * 72 + lt_] = (bf16_t)(vraw.y & 0xffffu); VTs[(dv4 + 3) * 72 + lt_] = (bf16_t)(vraw.y >> 16); } } while (0)
    ML_LOAD(0);
    ML_STAGE(0);
    ML_LOAD(1);
    float adec_cur = adec;
    for (int c = 0; c < 32; ++c) {
        const int tok0 = b * TSEQ + c * 64;
        LAS float* gl = gl0 + (c & 1) * 256; LAS bf16_t* VTs = VT0 + (c & 1) * (48 * 72);
        const int lt = w >> 1, dvt = w & 1; const f32x4 z4 = {0.f, 0.f, 0.f, 0.f};
        LDS_BAR();
#pragma unroll
        for (int sti = 0; sti < 2; ++sti) { const int st = (w & 1) * 2 + sti;
            f32x4 acc = {0.f, 0.f, 0.f, 0.f};
            if (st <= lt) acc = mma_tile(Qs + lt * 16 * 136, 136, Ks + st * 16 * 136, 136, 128, acc, lane);
            const int s = st * 16 + r16; const float us = gl[64 + s];
#pragma unroll
            for (int j = 0; j < 4; ++j) { const int l = lt * 16 + q4 * 4 + j; const float c1l = gl[l];
                const float d = (s <= l) ? fexp(c1l + us) : 0.f; Ss[l * 72 + s] = f2bf(acc[j] * d); } }
        const f32x4 nx = mma_tile(Cs + dvt * 16 * 136, 136, Qs + lt * 16 * 136, 136, 128, z4, lane);
        const f32x4 dx = mma_tile(Cs + 32 * 136, 136, Qs + lt * 16 * 136, 136, 128, z4, lane);
#pragma unroll
        for (int d3 = 0; d3 < 3; ++d3) { f32x4 acc = accC[d3] * adec_cur; const int gsw = ((2 * w + (r16 >> 3)) & 7) << 3;
#pragma unroll
            for (int ks = 0; ks < 2; ++ks) { const bf16x8 a = *(const LAS bf16x8*)(VTs + (d3 * 16 + r16) * 72 + ks * 32 + q4 * 8);
                const bf16x8 bb8 = *(const LAS bf16x8*)(KTs + (w * 16 + r16) * 72 + ((ks * 32 + q4 * 8) ^ gsw)); acc = MFMA16(a, bb8, acc); }
            accC[d3] = acc; }
        LDS_BAR();
        { const f32x4 ni = mma_tile(VTs + dvt * 16 * 72, 72, Ss + lt * 16 * 72, 72, 64, z4, lane);
          const f32x4 di = mma_tile(VTs + 32 * 72, 72, Ss + lt * 16 * 72, 72, 64, z4, lane);
          const int l = lt * 16 + r16; const float rl = gl[128 + l], ndl = gl[192 + l];
          float hv[4];
#pragma unroll
          for (int j = 0; j < 4; ++j) { const float den = di[j] + rl * dx[j]; hv[j] = (ni[j] + rl * nx[j]) * frcp(fmaxf(fabsf(den), ndl)); }
          u32x2 wv; wv.x = pk2(hv[0], hv[1]); wv.y = pk2(hv[2], hv[3]);
          *(u32x2*)(p.A2 + (size_t)(tok0 + l) * DM + h * 128 + dvs * 32 + dvt * 16 + q4 * 4) = wv; }
#pragma unroll
        for (int d3 = 0; d3 < 3; ++d3)
#pragma unroll
            for (int j = 0; j < 4; ++j) Cs[(d3 * 16 + q4 * 4 + j) * 136 + w * 16 + r16] = f2bf(accC[d3][j]);
        if (c + 1 < 32) { ML_STAGE(c + 1); adec_cur = adec; if (c + 2 < 32) ML_LOAD(c + 2); }
    }
#undef ML_LOAD
#undef ML_STAGE
}
__device__ __forceinline__ void phase_mlstm_fin(const P& p) {
    const int tid = otid(), lane = tid & 63; const int gw = blockIdx.x * 8 + (tid >> 6), NGW = gridDim.x * 8;
    float gn[8];
#pragma unroll
    for (int i = 0; i < 8; ++i) gn[i] = p.mlgn[lane * 8 + i];
    for (int tok0 = gw; tok0 < MTOK; tok0 += 4 * NGW) {
        u32x4 hv[4], ov[4];
#pragma unroll
        for (int r = 0; r < 4; ++r) { const int tok = tok0 + r * NGW; if (tok < MTOK) { hv[r] = *((const u32x4*)(p.A2 + (size_t)tok * DM) + lane); ov[r] = *((const u32x4*)(p.big + (size_t)tok * LDP + C_MO) + lane); } }
#pragma unroll
        for (int r = 0; r < 4; ++r) { const int tok = tok0 + r * NGW; if (tok < MTOK) {
            float v[8]; float s = 0.f;
#pragma unroll
            for (int i = 0; i < 4; ++i) { v[2 * i] = __uint_as_float(hv[r][i] << 16); v[2 * i + 1] = __uint_as_float(hv[r][i] & 0xffff0000u); s += v[2 * i] * v[2 * i] + v[2 * i + 1] * v[2 * i + 1]; }
            s += __shfl_xor(s, 1); s += __shfl_xor(s, 2); s += __shfl_xor(s, 4); s += __shfl_xor(s, 8);
            const float rs = rsqrtf(s * (1.0f / 128.0f) + EPS);
            float y[8];
#pragma unroll
            for (int i = 0; i < 8; ++i) { const float o = (i & 1) ? __uint_as_float(ov[r][i >> 1] & 0xffff0000u) : __uint_as_float(ov[r][i >> 1] << 16);
                y[i] = v[i] * rs * gn[i] * sigmoidf_(o); }
            u32x4 w; w.x = pk2(y[0], y[1]); w.y = pk2(y[2], y[3]); w.z = pk2(y[4], y[5]); w.w = pk2(y[6], y[7]);
            *((u32x4*)(p.A2 + (size_t)tok * DM) + lane) = w; } }
    }
}

template <int MODE, bool BND, bool FAST>
__device__ __forceinline__ void nsa_step(const LAS bf16_t* Kb, const LAS bf16_t* VbT, int j, int jt, int th, int q4, int r16, unsigned mk0, unsigned mk1,
                                         const bf16x8 (&bq)[2][2], f32x4 (&O)[4][2], float (&mrow)[2], float (&lrow)[2]) {
        bf16x8 pb[2][2];
#pragma unroll
        for (int rt = 0; rt < 2; ++rt) {
            f32x4 s[4];
#pragma unroll
            for (int kt = 0; kt < 4; ++kt) {
                const bf16x8 a0 = *(const LAS bf16x8*)(Kb + (kt * 16 + r16) * 72 + q4 * 8), a1 = *(const LAS bf16x8*)(Kb + (kt * 16 + r16) * 72 + 32 + q4 * 8);
                f32x4 acc = {0.f, 0.f, 0.f, 0.f}; acc = MFMA16(a0, bq[rt][0], acc); acc = MFMA16(a1, bq[rt][1], acc); s[kt] = acc;
            }
            const int t = jt * 64 + th * 32 + rt * 16 + r16; const unsigned mk = rt ? mk1 : mk0;
            const bool rowsel = (MODE == 0) ? (((mk >> j) & 1u) != 0u) : true;
            const float NINF = -__builtin_inff(), CS = 0.125f * 1.4426950408889634f;
            if (BND) {
#pragma unroll
                for (int kt = 0; kt < 4; ++kt)
#pragma unroll
                    for (int i = 0; i < 4; ++i) { const int pos = j * 64 + kt * 16 + q4 * 4 + i;
                        const bool valid = (pos <= t) && (MODE == 0 || pos > t - 512); s[kt][i] = valid ? s[kt][i] : NINF; }
            }
            if (FAST) {
                const float mcp = rowsel ? mrow[rt] * CS : __builtin_inff();
                f32x4 ps4 = {0.f, 0.f, 0.f, 0.f};
#pragma unroll
                for (int kt = 0; kt < 4; ++kt) { f32x4 e = s[kt] * CS - mcp;
                    e[0] = __builtin_amdgcn_exp2f(e[0]); e[1] = __builtin_amdgcn_exp2f(e[1]); e[2] = __builtin_amdgcn_exp2f(e[2]); e[3] = __builtin_amdgcn_exp2f(e[3]); s[kt] = e; ps4 = ps4 + e; }
                lrow[rt] += (ps4[0] + ps4[1]) + (ps4[2] + ps4[3]);
            } else {
            f32x4 m4 = __builtin_elementwise_max(__builtin_elementwise_max(s[0], s[1]), __builtin_elementwise_max(s[2], s[3]));
            float mx = fmaxf(fmaxf(m4[0], m4[1]), fmaxf(m4[2], m4[3]));
            mx = fmaxf(mx, __shfl_xor(mx, 16)); mx = fmaxf(mx, __shfl_xor(mx, 32));
            const float mnew = fmaxf(mrow[rt], rowsel ? mx : NINF);
            const float mc = (mnew == NINF) ? 0.f : mnew * CS;
            const float alpha = __builtin_amdgcn_exp2f(mrow[rt] * CS - mc); mrow[rt] = mnew;
            const float mcp = rowsel ? mc : __builtin_inff();
            f32x4 ps4 = {0.f, 0.f, 0.f, 0.f};
#pragma unroll
            for (int kt = 0; kt < 4; ++kt) { f32x4 e = s[kt] * CS - mcp;
                e[0] = __builtin_amdgcn_exp2f(e[0]); e[1] = __builtin_amdgcn_exp2f(e[1]); e[2] = __builtin_amdgcn_exp2f(e[2]); e[3] = __builtin_amdgcn_exp2f(e[3]); s[kt] = e; ps4 = ps4 + e; }
            lrow[rt] = lrow[rt] * alpha + ((ps4[0] + ps4[1]) + (ps4[2] + ps4[3]));
#pragma unroll
            for (int dt = 0; dt < 4; ++dt) O[dt][rt] = O[dt][rt] * alpha;
            }
#pragma unroll
            for (int kk = 0; kk < 2; ++kk) { u32x4 t4; t4.x = pk2(s[2 * kk][0], s[2 * kk][1]); t4.y = pk2(s[2 * kk][2], s[2 * kk][3]);
                t4.z = pk2(s[2 * kk + 1][0], s[2 * kk + 1][1]); t4.w = pk2(s[2 * kk + 1][2], s[2 * kk + 1][3]); pb[rt][kk] = __builtin_bit_cast(bf16x8, t4); }
        }
#pragma unroll
        for (int kk = 0; kk < 2; ++kk) {
#pragma unroll
            for (int dt = 0; dt < 4; ++dt) {
                const u32x2 lo = *(const LAS u32x2*)(VbT + (dt * 16 + r16) * 72 + (2 * kk) * 16 + q4 * 4), hi = *(const LAS u32x2*)(VbT + (dt * 16 + r16) * 72 + (2 * kk + 1) * 16 + q4 * 4);
                u32x4 a4; a4.x = lo.x; a4.y = lo.y; a4.z = hi.x; a4.w = hi.y; const bf16x8 a = __builtin_bit_cast(bf16x8, a4);
#pragma unroll
                for (int rt = 0; rt < 2; ++rt) O[dt][rt] = MFMA16(a, pb[rt][kk], O[dt][rt]);
            }
        }
}

template <int MODE>
__device__ __forceinline__ void nsa_branch(const bf16_t* proj, LAS bf16_t* Kb0, LAS bf16_t* VbT0, int b, int g, int jt, int jlo, int jhi, unsigned umask, unsigned mk0, unsigned mk1,
                                           const bf16x8 (&bq)[2][2], f32x4 (&O)[4][2], float (&mrow)[2], float (&lrow)[2], int kcol, int vcol, bool fast) {
    const int tid = otid(), lane = tid & 63, w = tid >> 6, q4 = lane >> 4, r16 = lane & 15, th = w & 1;
    unsigned todo = (MODE == 0) ? umask : 0xffffffffu;
    todo &= (jhi >= 31 ? 0xffffffffu : ((1u << (jhi + 1)) - 1u)) & ~((1u << jlo) - 1u);
    const bf16_t* gbase = proj + (size_t)(b * TSEQ + lane) * LDP + g * 64 + w * 8;
    int j = todo ? __builtin_ctz(todo) : 64;
    u32x4 kv, vv;
    if (j < 64) { kv = *(const u32x4*)(gbase + (size_t)j * 64 * LDP + kcol); vv = *(const u32x4*)(gbase + (size_t)j * 64 * LDP + vcol); }
    LDS_BAR();
    int buf = 0;
    if (j < 64) { *(LAS u32x4*)(Kb0 + lane * 72 + w * 8) = kv;
#pragma unroll
        for (int e = 0; e < 4; ++e) { VbT0[(w * 8 + 2 * e) * 72 + lane] = (bf16_t)(vv[e] & 0xffffu); VbT0[(w * 8 + 2 * e + 1) * 72 + lane] = (bf16_t)(vv[e] >> 16); } }
    LDS_BAR();
    while (j < 64) {
        todo &= todo - 1u;
        const int jn = todo ? __builtin_ctz(todo) : 64;
        if (jn < 64) { kv = *(const u32x4*)(gbase + (size_t)jn * 64 * LDP + kcol); vv = *(const u32x4*)(gbase + (size_t)jn * 64 * LDP + vcol); }
        LAS bf16_t* Kb = Kb0 + buf * (2 * 64 * 72); LAS bf16_t* VbT = VbT0 + buf * (2 * 64 * 72);
        const bool need = (MODE == 1) || (__builtin_amdgcn_ballot_w64((((mk0 | mk1) >> j) & 1u) != 0u) != 0ull);
        const bool interior = (j < jt) && (MODE == 0 || j > jt - 8);
        if (need) {
            if (fast) {
                if (interior) nsa_step<MODE, false, true>(Kb, VbT, j, jt, th, q4, r16, mk0, mk1, bq, O, mrow, lrow);
                else { asm volatile("; boundary block" ::: "memory"); nsa_step<MODE, true, true>(Kb, VbT, j, jt, th, q4, r16, mk0, mk1, bq, O, mrow, lrow); }
            } else {
                asm volatile("; exact running-max path" ::: "memory");
                if (interior) nsa_step<MODE, false, false>(Kb, VbT, j, jt, th, q4, r16, mk0, mk1, bq, O, mrow, lrow);
                else { asm volatile("; boundary block" ::: "memory"); nsa_step<MODE, true, false>(Kb, VbT, j, jt, th, q4, r16, mk0, mk1, bq, O, mrow, lrow); }
            }
        }
        if (jn < 64) { LAS bf16_t* Kn = Kb0 + (buf ^ 1) * (2 * 64 * 72); LAS bf16_t* Vn = VbT0 + (buf ^ 1) * (2 * 64 * 72);
            *(LAS u32x4*)(Kn + lane * 72 + w * 8) = kv;
#pragma unroll
            for (int e = 0; e < 4; ++e) { Vn[(w * 8 + 2 * e) * 72 + lane] = (bf16_t)(vv[e] & 0xffffu); Vn[(w * 8 + 2 * e + 1) * 72 + lane] = (bf16_t)(vv[e] >> 16); } }
        LDS_BAR();
        j = jn; buf ^= 1;
    }
}

__device__ __forceinline__ void nsa_unit(const P& p, LAS unsigned char* lds, int b, int g, int jt) {
    const int tid = otid(), lane = tid & 63, w = tid >> 6, q4 = lane >> 4, r16 = lane & 15, hh = w >> 1, th = w & 1;
    const bf16_t* proj = p.big;
    LAS bf16_t* KC = (LAS bf16_t*)lds;
    LAS bf16_t* VCT = KC + 128 * 72;
    LAS float* impP = (LAS float*)(VCT + 64 * 136);
    LAS float* impS = impP + 4 * 64 * 33;
    LAS unsigned* selm = (LAS unsigned*)(impS + 64 * 33);
    LAS bf16_t* Kb = (LAS bf16_t*)(selm + 80);
    LAS bf16_t* VbT = Kb + 64 * 72;
    const int head = g * 4 + hh;
    bf16x8 bq[2][2];
#pragma unroll
    for (int rt = 0; rt < 2; ++rt)
#pragma unroll
        for (int ks = 0; ks < 2; ++ks) bq[rt][ks] = *(const bf16x8*)(proj + (size_t)(b * TSEQ + jt * 64 + th * 32 + rt * 16 + r16) * LDP + C_NQ + head * 64 + ks * 32 + q4 * 8);
    float qnorm[2];
#pragma unroll
    for (int rt = 0; rt < 2; ++rt) { float q2 = 0.f;
#pragma unroll
        for (int ks = 0; ks < 2; ++ks)
#pragma unroll
            for (int e = 0; e < 8; ++e) { const float qv = __uint_as_float(((unsigned)(unsigned short)bq[rt][ks][e]) << 16); q2 += qv * qv; }
        q2 += __shfl_xor(q2, 16); q2 += __shfl_xor(q2, 32); qnorm[rt] = sqrtf(q2); }
    bf16_t graw[2][3];
#pragma unroll
    for (int rt = 0; rt < 2; ++rt)
#pragma unroll
        for (int br = 0; br < 3; ++br) graw[rt][br] = proj[(size_t)(b * TSEQ + jt * 64 + th * 32 + rt * 16 + r16) * LDP + C_NG + head * 3 + br];
#define NSA_GATE(rt, br) sigmoidf_(bf2f(graw[rt][br]))
    __syncthreads();
    { const bf16_t* kc = p.KCb + (size_t)((0 * 16 + b) * 2 + g) * 128 * 64; const bf16_t* vc = p.KCb + (size_t)((1 * 16 + b) * 2 + g) * 128 * 64;
#pragma unroll
      for (int i = 0; i < 2; ++i) { const int row = tid & 127, c8 = ((tid >> 7) + 4 * i) * 8;
          const u32x4 kv = *(const u32x4*)(kc + row * 64 + c8); const u32x4 vv = *(const u32x4*)(vc + row * 64 + c8);
          *(LAS u32x4*)(KC + row * 72 + c8) = kv;
#pragma unroll
          for (int e = 0; e < 4; ++e) { VCT[(c8 + 2 * e) * 136 + row] = (bf16_t)(vv[e] & 0xffffu); VCT[(c8 + 2 * e + 1) * 136 + row] = (bf16_t)(vv[e] >> 16); } }
      if (tid == 0) selm[64] = 0u; }
    __syncthreads();
    f32x4 oacc[4][2];
#pragma unroll
    for (int rt = 0; rt < 2; ++rt) {
        f32x4 sa[8];
#pragma unroll
        for (int nt = 0; nt < 8; ++nt) {
            const bf16x8 a0 = *(const LAS bf16x8*)(KC + (nt * 16 + r16) * 72 + q4 * 8), a1 = *(const LAS bf16x8*)(KC + (nt * 16 + r16) * 72 + 32 + q4 * 8);
            f32x4 acc = {0.f, 0.f, 0.f, 0.f}; acc = MFMA16(a0, bq[rt][0], acc); acc = MFMA16(a1, bq[rt][1], acc); sa[nt] = acc;
        }
        const int t = jt * 64 + th * 32 + rt * 16 + r16; const int nval = (t >= 31) ? ((t - 31) / 16 + 1) : 0;
        float mx = -1e30f;
#pragma unroll
        for (int nt = 0; nt < 8; ++nt)
#pragma unroll
            for (int i = 0; i < 4; ++i) { const int n = nt * 16 + q4 * 4 + i; const float sv = (n < nval) ? sa[nt][i] * 0.125f : -1e30f; sa[nt][i] = sv; mx = fmaxf(mx, sv); }
        mx = fmaxf(mx, __shfl_xor(mx, 16)); mx = fmaxf(mx, __shfl_xor(mx, 32));
        float sum = 0.f;
#pragma unroll
        for (int nt = 0; nt < 8; ++nt)
#pragma unroll
            for (int i = 0; i < 4; ++i) { const float sv = sa[nt][i]; const float pv = (sv > -1e29f) ? fexp(sv - mx) : 0.f; sa[nt][i] = pv; sum += pv; }
        sum += __shfl_xor(sum, 16); sum += __shfl_xor(sum, 32);
        const float inv = sum > 0.f ? frcp(sum) : 0.f;
#pragma unroll
        for (int nt = 0; nt < 8; ++nt) sa[nt] = sa[nt] * inv;
        float sh[8];
#pragma unroll
        for (int nt = 0; nt < 8; ++nt) sh[nt] = __shfl(0.5f * sa[nt][3], (lane + 48) & 63);
#pragma unroll
        for (int nt = 0; nt < 8; ++nt) { const float own = (sa[nt][0] + sa[nt][1]) + (sa[nt][2] + 0.5f * sa[nt][3]);
            const float spin = (q4 > 0) ? sh[nt] : (nt > 0 ? sh[nt > 0 ? nt - 1 : 0] : 0.f);
            impP[(hh * 64 + th * 32 + rt * 16 + r16) * 33 + nt * 4 + q4] = own + spin; }
        f32x4 oc[4];
#pragma unroll
        for (int dt = 0; dt < 4; ++dt) oc[dt] = (f32x4){0.f, 0.f, 0.f, 0.f};
#pragma unroll
        for (int kk = 0; kk < 4; ++kk) {
            u32x4 t4; t4.x = pk2(sa[2 * kk][0], sa[2 * kk][1]); t4.y = pk2(sa[2 * kk][2], sa[2 * kk][3]);
            t4.z = pk2(sa[2 * kk + 1][0], sa[2 * kk + 1][1]); t4.w = pk2(sa[2 * kk + 1][2], sa[2 * kk + 1][3]); const bf16x8 pb = __builtin_bit_cast(bf16x8, t4);
#pragma unroll
            for (int dt = 0; dt < 4; ++dt) {
                const u32x2 lo = *(const LAS u32x2*)(VCT + (dt * 16 + r16) * 136 + (2 * kk) * 16 + q4 * 4), hi = *(const LAS u32x2*)(VCT + (dt * 16 + r16) * 136 + (2 * kk + 1) * 16 + q4 * 4);
                u32x4 a4; a4.x = lo.x; a4.y = lo.y; a4.z = hi.x; a4.w = hi.y; const bf16x8 a = __builtin_bit_cast(bf16x8, a4);
                oc[dt] = MFMA16(a, pb, oc[dt]);
            }
        }
        const float g0 = NSA_GATE(rt, 0);
#pragma unroll
        for (int dt = 0; dt < 4; ++dt) oacc[dt][rt] = oc[dt] * g0;
    }
    __syncthreads();
    { const int tok = tid >> 3, part = tid & 7;
#pragma unroll
      for (int i = 0; i < 4; ++i) { const int jb = part * 4 + i;
          impS[tok * 33 + jb] = ((impP[(0 * 64 + tok) * 33 + jb] + impP[(1 * 64 + tok) * 33 + jb]) + impP[(2 * 64 + tok) * 33 + jb]) + impP[(3 * 64 + tok) * 33 + jb]; }
      __syncthreads();
      unsigned bits = 0u;
      if (jt >= 16) {
          float v[32];
#pragma unroll
          for (int j2 = 0; j2 < 32; ++j2) v[j2] = impS[tok * 33 + j2];
#pragma unroll
          for (int i = 0; i < 4; ++i) { const int jb = part * 4 + i;
              const bool forced = (jb == 0) || (jb == jt) || (jb == jt - 1);
              const float vb = impS[tok * 33 + jb]; int rank = 0;
#pragma unroll
              for (int j2 = 1; j2 < 31; ++j2) rank += ((j2 <= jt - 2) && (v[j2] > vb || (v[j2] == vb && j2 < jb))) ? 1 : 0;
              if (forced || (jb >= 1 && jb <= jt - 2 && rank < 13)) bits |= 1u << jb; }
      } else {
#pragma unroll
          for (int i = 0; i < 4; ++i) { const int jb = part * 4 + i; if (jb <= jt) bits |= 1u << jb; }
      }
      bits |= __shfl_xor(bits, 1); bits |= __shfl_xor(bits, 2); bits |= __shfl_xor(bits, 4);
      if (part == 0) { selm[tok] = bits; atomicOr((unsigned*)(selm + 64), bits); }
    }
    __syncthreads();
    const unsigned umask = selm[64], mk0 = selm[th * 32 + r16], mk1 = selm[th * 32 + 16 + r16];
    LAS float* stash = (LAS float*)lds + w * 2048 + lane;
#pragma unroll
    for (int dt = 0; dt < 4; ++dt)
#pragma unroll
        for (int rt = 0; rt < 2; ++rt)
#pragma unroll
            for (int i = 0; i < 4; ++i) stash[((dt * 2 + rt) * 4 + i) * 64] = oacc[dt][rt][i];
#pragma unroll
    for (int br = 0; br < 2; ++br) {
        f32x4 O[4][2]; float mrow[2], lrow[2] = {0.f, 0.f};
        const float kmax = sqrtf(__uint_as_float(p.kmx[(b * 2 + g) * 2 + br]));
        const float bnd0 = qnorm[0] * kmax * 1.002f + 0.1f, bnd1 = qnorm[1] * kmax * 1.002f + 0.1f;
        const bool fast = __builtin_amdgcn_ballot_w64(!(bnd0 * 0.125f <= 40.f && bnd1 * 0.125f <= 40.f)) == 0ull;
        mrow[0] = fast ? bnd0 : -__builtin_inff(); mrow[1] = fast ? bnd1 : -__builtin_inff();
#pragma unroll
        for (int dt = 0; dt < 4; ++dt) { O[dt][0] = (f32x4){0.f, 0.f, 0.f, 0.f}; O[dt][1] = (f32x4){0.f, 0.f, 0.f, 0.f}; }
#ifndef NO_BR
        if (br == 0) nsa_branch<0>(proj, Kb, VbT, b, g, jt, 0, jt, umask, mk0, mk1, bq, O, mrow, lrow, C_KS, C_VS, fast);
        else nsa_branch<1>(proj, Kb, VbT, b, g, jt, (jt >= 8 ? jt - 8 : 0), jt, umask, mk0, mk1, bq, O, mrow, lrow, C_KW, C_VW, fast);
#endif
#pragma unroll
        for (int rt = 0; rt < 2; ++rt) { float l = lrow[rt]; l += __shfl_xor(l, 16); l += __shfl_xor(l, 32);
            const float sc = (l > 0.f) ? NSA_GATE(rt, br + 1) * frcp(l) : 0.f;
#pragma unroll
            for (int dt = 0; dt < 4; ++dt) { f32x4 v = O[dt][rt] * sc;
#pragma unroll
                for (int i = 0; i < 4; ++i) v[i] += stash[((dt * 2 + rt) * 4 + i) * 64];
                if (br == 0) {
#pragma unroll
                    for (int i = 0; i < 4; ++i) stash[((dt * 2 + rt) * 4 + i) * 64] = v[i];
                } else { u32x2 wv; wv.x = pk2(v[0], v[1]); wv.y = pk2(v[2], v[3]);
                    *(u32x2*)(p.A2 + (size_t)(b * TSEQ + jt * 64 + th * 32 + rt * 16 + r16) * DM + 512 + head * 64 + dt * 16 + q4 * 4) = wv; } } }
    }
}

__device__ __forceinline__ void phase_final(const P& p) {
    const int tid = otid(), lane = tid & 63; const int gw = blockIdx.x * 8 + (tid >> 6), NGW = gridDim.x * 8;
    f32x4 gq[4];
#pragma unroll
    for (int j = 0; j < 4; ++j) gq[j] = *((const f32x4*)p.fnorm + lane + 64 * j);
    for (int row0 = gw; row0 < MTOK; row0 += 4 * NGW) {
        u32x2 rb[4][4]; float rs[4];
#pragma unroll
        for (int r = 0; r < 4; ++r) { const int row = row0 + r * NGW; if (row < MTOK) { const u32x2* xi = (const u32x2*)(p.xb + (size_t)row * DM) + lane;
#pragma unroll
            for (int j = 0; j < 4; ++j) rb[r][j] = __builtin_nontemporal_load(xi + 64 * j);
            rs[r] = rsqrtf(p.ssq[3 * MTOK + row] * (1.0f / DM) + EPS); } }
#pragma unroll
        for (int r = 0; r < 4; ++r) { const int row = row0 + r * NGW; if (row < MTOK) { f32x4* o = (f32x4*)(p.out + (size_t)row * DM) + lane;
#pragma unroll
            for (int j = 0; j < 4; ++j) { f32x4 v;
                v[0] = __uint_as_float(rb[r][j].x << 16); v[1] = __uint_as_float(rb[r][j].x & 0xffff0000u); v[2] = __uint_as_float(rb[r][j].y << 16); v[3] = __uint_as_float(rb[r][j].y & 0xffff0000u);
                __builtin_nontemporal_store(v * rs[r] * gq[j], o + 64 * j); } } }
    }
}

#define XB_TMO      128
#define XB_XCNT(j)  (256  + 64 * (j))
#define XB_XSUB(j)  (1280 + 64 * (j))
#define XB_XGEN(j)  (2304 + 64 * (j))
#define XB_TOP      3328
#define XB_TOPGEN   3392
#define XCD_BAR_WORDS 3456
#define XB_SPIN_CAP (1u << 18)
__device__ __forceinline__ unsigned xb_ld(unsigned* p)              { return __hip_atomic_load(p, __ATOMIC_RELAXED, __HIP_MEMORY_SCOPE_AGENT); }
__device__ __forceinline__ unsigned xb_add(unsigned* p, unsigned v) { return __hip_atomic_fetch_add(p, v, __ATOMIC_RELAXED, __HIP_MEMORY_SCOPE_AGENT); }
__device__ __forceinline__ unsigned xb_xcc_id() { return (unsigned)__builtin_amdgcn_s_getreg((3 << 11) | 20) & 0xFu; }
#define XB_SPIN(cond, bar) do { unsigned _sp = 0; while (cond) { __builtin_amdgcn_s_sleep(1); \
    if ((++_sp & 255u) == 0u) { if (xb_ld(&(bar)[XB_TMO])) break; if (_sp > XB_SPIN_CAP) { atomicAdd(&(bar)[XB_TMO], 1u); break; } } } } while (0)
struct XcdBarrier { unsigned* bar; unsigned x; volatile LAS unsigned* st; };
__device__ __forceinline__ XcdBarrier xcd_barrier_post(unsigned* bar, volatile LAS unsigned* st) {
    XcdBarrier b; b.bar = bar; b.x = xb_xcc_id(); b.st = st;
    if (threadIdx.x == 0) (void)xb_add(&bar[XB_XCNT(b.x)], 1u);
    return b;
}
__device__ __forceinline__ void xcd_barrier_complete(unsigned* bar, unsigned x, unsigned& nloc, unsigned& nx) {
    const unsigned G = gridDim.x * gridDim.y * gridDim.z;
    unsigned sum, cnt, mine, sp = 0u;
    for (;;) {
        sum = 0u; cnt = 0u; mine = 0u;
#pragma unroll
        for (unsigned j = 0; j < 16; ++j) { const unsigned c = xb_ld(&bar[XB_XCNT(j)]); sum += c; cnt += (c > 0u) ? 1u : 0u; mine = (j == x) ? c : mine; }
        if (sum == G) break;
        __builtin_amdgcn_s_sleep(1);
        if ((++sp & 255u) == 0u) { if (xb_ld(&bar[XB_TMO])) break; if (sp > XB_SPIN_CAP) { atomicAdd(&bar[XB_TMO], 1u); break; } }
    }
    nloc = mine > 0u ? mine : 1u; nx = cnt > 0u ? cnt : 1u;
}
__device__ __forceinline__ void xcd_barrier(const XcdBarrier& b) {
    asm volatile("s_waitcnt vmcnt(0)" ::: "memory");
    __syncthreads();
    if (threadIdx.x == 0) {
        unsigned* bar = b.bar;
        __builtin_amdgcn_s_waitcnt(0);
        unsigned nloc = b.st[0], nx = b.st[1];
        if (nloc == 0u) { xcd_barrier_complete(bar, b.x, nloc, nx); b.st[0] = nloc; b.st[1] = nx; }
        const unsigned old = xb_add(&bar[XB_XSUB(b.x)], 1u);
        const unsigned gen = old / nloc;
        if (old + 1u == (gen + 1u) * nloc) {
            __builtin_amdgcn_fence(__ATOMIC_RELEASE, "agent");
            asm volatile("s_waitcnt vmcnt(0)" ::: "memory");
            const unsigned og = xb_add(&bar[XB_TOP], 1u);
            const unsigned tg = og / nx;
            if (og + 1u == (tg + 1u) * nx) xb_add(&bar[XB_TOPGEN], 1u);
            else XB_SPIN(xb_ld(&bar[XB_TOPGEN]) == tg, bar);
            __builtin_amdgcn_fence(__ATOMIC_ACQUIRE, "agent");
            xb_add(&bar[XB_XGEN(b.x)], 1u);
            asm volatile("s_waitcnt vmcnt(0)" ::: "memory");
        } else {
            XB_SPIN(xb_ld(&bar[XB_XGEN(b.x)]) == gen, bar);
            __builtin_amdgcn_fence(__ATOMIC_ACQUIRE, "agent");
            asm volatile("s_waitcnt vmcnt(0)" ::: "memory");
        }
    }
    __syncthreads();
}

constexpr int NPHASE = 11;
#ifndef PH_MASK
#define PH_MASK 0x7ff
#endif
template <int ph>
__device__ __forceinline__ void run_phase(const P& p, LAS unsigned char* lds) {
    if (!((PH_MASK >> ph) & 1)) return;
    const int G = gridDim.x, c = blockIdx.x;
    pg8::Order S; S.G = G; S.c = c; S.nZ = 1; S.az0 = S.az1 = S.bz1 = 0;
    switch (ph) {
    case 0: phase_prep(p, lds); break;
    case 1: case 8: {
        S.nM = MTOK / 256; S.nN = 22; S.A = (const char*)p.xb; S.Bt = (const char*)(ph == 1 ? p.Wup1 : p.Wup2); S.a_tile = (size_t)256 * DM * 2; S.b_tile = (size_t)256 * DM * 2;
        EpiUp E{p.big, p.ssq + (ph == 1 ? 0 : 2) * MTOK};
        pg8::gemm_phase(lds, pg8::Dims{DM, DM, 64}, S, E); } break;
    case 2: case 9: {
        S.nM = MTOK / 256; S.nN = 4; S.A = (const char*)p.big; S.Bt = (const char*)(ph == 2 ? p.Wdn1 : p.Wdn2); S.a_tile = (size_t)256 * FF * 2; S.b_tile = (size_t)256 * FF * 2;
        EpiRes E{(const float*)nullptr, p.xb, p.ssq + (ph == 2 ? 1 : 3) * MTOK, 0.5f};
        pg8::gemm_phase<EpiRes, true>(lds, pg8::Dims{FF, 64, 256 * 64}, S, E); } break;
    case 3: {
        S.nM = MTOK / 256; S.nN = 14; S.A = (const char*)p.xb; S.Bt = (const char*)p.Wint; S.a_tile = (size_t)256 * DM * 2; S.b_tile = (size_t)256 * DM * 2;
        EpiProj E{p.big, p.ssq + MTOK};
        pg8::gemm_phase(lds, pg8::Dims{DM, DM, 64}, S, E); } break;
    case 4: {
        S.nM = 8; S.nN = 2; S.nZ = 4; S.A = (const char*)(p.big + C_KC); S.Bt = (const char*)p.Wc1t;
        S.az0 = 64 * 2; S.az1 = 128 * 2; S.bz1 = (size_t)512 * 1024 * 2; S.a_tile = (size_t)256 * 16 * LDP * 2; S.b_tile = (size_t)256 * 1024 * 2;
        EpiUV E{p.UV};
        if (G > 128) {
            if (c < 64) { pg8::gemm_phase(lds, pg8::Dims{1024, 16 * LDP, LDP}, S, E); phase_prep_late(p, lds, c, 64, 1000, 1 << 30); }
            else { phase_kmax(p, c - 64, G - 64); phase_gates(p, c - 64, G - 64); phase_conv(p, c - 64, G - 64); phase_prep_late(p, lds, c - 64, G - 64, 0, 1000); }
        } else { pg8::gemm_phase(lds, pg8::Dims{1024, 16 * LDP, LDP}, S, E); phase_prep_late(p, lds, c, G, 0, 1 << 30); phase_kmax(p, c, G); phase_gates(p, c, G); phase_conv(p, c, G); } } break;
    case 5: {
        phase_cmp2(p, lds);
        if (G == 256) { const int x = c & 7, m = c >> 3; mlstm_unit(p, lds, ((x * 8 + (m >> 2)) << 2) | (m & 3)); }
        else for (int u = c; u < 256; u += G) mlstm_unit(p, lds, u); } break;
    case 6: {
        phase_mlstm_fin(p);
#ifndef NSA_REP
#define NSA_REP 1
#endif
        for (int rep = 0; rep < NSA_REP; ++rep)
        if (G == 256) {
            const int x = c & 7, m = c >> 3;
            for (int i = 0; i < 4; ++i) { const int bg = x * 4 + i; const int mm = (i & 2) ? ((m + 16) & 31) : m; const int jt = (i & 1) ? 31 - mm : mm;
                nsa_unit(p, lds, bg >> 1, bg & 1, jt); }
        } else
        for (int i = 0; c + i * G < 1024; ++i) { const int u = c + i * G; const int k = u >> 5, bg = u & 31;
            const int rnd = k >> 3, kk = k & 7; const int jt = (rnd == 0) ? 31 - kk : (rnd == 1) ? 16 + kk : (rnd == 2) ? 15 - kk : kk;
            nsa_unit(p, lds, bg >> 1, bg & 1, jt); } } break;
    case 7: {
        S.nM = MTOK / 256; S.nN = 4; S.A = (const char*)p.A2; S.Bt = (const char*)p.Woutt; S.a_tile = (size_t)256 * DM * 2; S.b_tile = (size_t)256 * DM * 2;
        EpiRes E{(const float*)nullptr, p.xb, p.ssq + 2 * MTOK, 1.0f};
        pg8::gemm_phase(lds, pg8::Dims{DM, DM, 64}, S, E); } break;
    case 10: phase_final(p); break;
    }
}

__global__ __launch_bounds__(512) void mega(P p, int ph_lo, int ph_hi) {
    extern __shared__ __attribute__((aligned(16))) unsigned char shm[];
    LAS unsigned char* lds = (LAS unsigned char*)shm;
#if ONE_LAUNCH
    cg::grid_group grid = cg::this_grid();
    if (ph_lo < 0) grid.sync();
    volatile LAS unsigned* st = (volatile LAS unsigned*)(lds + 131072);
    if (threadIdx.x == 0) { st[0] = 0u; st[1] = 0u; st[2] = 0u; st[3] = 0u; }
    __syncthreads();
    const XcdBarrier xb = xcd_barrier_post(p.bar, st);
#ifndef REP_MASK
#define REP_MASK 0
#endif
#define RUNPH(k) if (ph_lo <= k && k <= ph_hi) { run_phase<k>(p, lds); if ((REP_MASK >> k) & 1) { xcd_barrier(xb); run_phase<k>(p, lds); } if (k < ph_hi) xcd_barrier(xb); }
#else
#define RUNPH(k) if (ph_lo <= k && k <= ph_hi) { run_phase<k>(p, lds); }
#endif
    RUNPH(0) RUNPH(1) RUNPH(2) RUNPH(3) RUNPH(4) RUNPH(5) RUNPH(6) RUNPH(7) RUNPH(8) RUNPH(9) RUNPH(10)
}

extern "C" void kernel_launch(void* const* d_in, const int* in_sizes, int n_in, void* d_out, int out_size, void* d_ws, size_t ws_size, hipStream_t stream) {
    constexpr size_t LDS_BYTES = 131072 + 16;
    static int grid = 0;
    if (grid == 0) {
        int dev = 0, cus = 0, per_cu = 0;
        hipGetDevice(&dev); hipDeviceGetAttribute(&cus, hipDeviceAttributeMultiprocessorCount, dev);
        hipFuncSetAttribute((const void*)mega, hipFuncAttributeMaxDynamicSharedMemorySize, (int)LDS_BYTES);
        hipOccupancyMaxActiveBlocksPerMultiprocessor(&per_cu, (const void*)mega, 512, LDS_BYTES);
        if (per_cu < 1) { fprintf(stderr, "occupancy query says %d blocks per CU\n", per_cu); per_cu = 1; }
        grid = cus * 1;
        (void)hipGetLastError();
    }
    P p{};
    const float** f = (const float**)d_in;
    p.x = f[0]; p.f1n = f[1]; p.f1w1 = f[2]; p.f1w3 = f[3]; p.f1w2 = f[4]; p.mixn = f[5]; p.win = f[6]; p.convw = f[7]; p.mlbi = f[8]; p.mlbf = f[9]; p.mlgn = f[10];
    p.kpe = f[11]; p.kw1 = f[12]; p.kb1 = f[13]; p.kw2 = f[14]; p.vpe = f[15]; p.vw1 = f[16]; p.vb1 = f[17]; p.vw2 = f[18]; p.wout = f[19];
    p.f2n = f[20]; p.f2w1 = f[21]; p.f2w3 = f[22]; p.f2w2 = f[23]; p.fnorm = f[24];
    p.out = (float*)d_out;
    char* ws = (char*)d_ws; size_t off = 0;
    auto take = [&](size_t bytes) { char* r = ws + off; off += (bytes + 255) & ~(size_t)255; return r; };
    p.Wup1 = (bf16_t*)take((size_t)5632 * 1024 * 2); p.Wdn1 = (bf16_t*)take((size_t)1024 * FF * 2);
    p.Wup2 = (bf16_t*)take((size_t)5632 * 1024 * 2); p.Wdn2 = (bf16_t*)take((size_t)1024 * FF * 2);
    p.Wint = (bf16_t*)take((size_t)LDP * 1024 * 2); p.Woutt = (bf16_t*)take((size_t)1024 * 1024 * 2); p.Wc1t = (bf16_t*)take((size_t)2 * 512 * 1024 * 2);
    p.xb = (bf16_t*)take((size_t)MTOK * DM * 2);
    p.big = (bf16_t*)take((size_t)MTOK * LDP * 2);
    p.A2 = (bf16_t*)take((size_t)MTOK * DM * 2);
    p.ssq = (float*)take((size_t)4 * MTOK * 4);
    p.UV = (float*)take((size_t)4 * 2048 * 512 * 4);
    p.b1f = (float*)take(512 * 4);
    p.KCb = (bf16_t*)take((size_t)2 * 16 * 2 * 128 * 64 * 2);
    p.kmx = (unsigned*)take(64 * 4);
    p.gat = (float*)take((size_t)64 * TSEQ * 16);
    p.qkc = (bf16_t*)take((size_t)MTOK * DM * 2);
    p.bar = (unsigned*)take(XCD_BAR_WORDS * 4);
    if (off > ws_size) { fprintf(stderr, "workspace too small: need %zu have %zu\n", off, ws_size); return; }
#if ONE_LAUNCH
    hipMemsetAsync(p.bar, 0, XCD_BAR_WORDS * 4, stream);
    int lo = 0, hi = NPHASE - 1;
    void* args[] = {&p, &lo, &hi};
    hipError_t e = hipLaunchCooperativeKernel((const void*)mega, dim3(grid), dim3(512), args, LDS_BYTES, stream);
    if (e != hipSuccess) fprintf(stderr, "cooperative launch failed: %s (grid %d)\n", hipGetErrorString(e), grid);
#else
    for (int ph = 0; ph < NPHASE; ++ph) mega<<<dim3(grid), dim3(512), LDS_BYTES, stream>>>(p, ph, ph);
#endif
}
```

```cpp
#include <hip/hip_runtime.h>
#include <hip/hip_cooperative_groups.h>
#include <cstdio>
#include <cstdint>
namespace cg = cooperative_groups;

#ifndef ONE_LAUNCH
#define ONE_LAUNCH 1
#endif

#define LAS __attribute__((address_space(3)))
typedef unsigned short bf16_t;
typedef short bf16x8 __attribute__((ext_vector_type(8)));
typedef short bf16x4 __attribute__((ext_vector_type(4)));
typedef float f32x4 __attribute__((ext_vector_type(4)));
typedef unsigned u32x4 __attribute__((ext_vector_type(4)));
typedef unsigned u32x2 __attribute__((ext_vector_type(2)));

constexpr int MTOK = 32768, DM = 1024, FF = 2816, TSEQ = 2048, NB = 16;
constexpr int LDP = 3584;
constexpr int C_MQ = 0, C_MK = 512, C_MV = 1024, C_MO = 1536, C_NQ = 2048, C_KC = 2560, C_VC = 2688, C_KS = 2816, C_VS = 2944, C_KW = 3072, C_VW = 3200, C_GI = 3328, C_GF = 3332, C_NG = 3336;
constexpr float EPS = 1e-6f;

__device__ __forceinline__ bf16_t f2bf(float f) { __bf16 b = (__bf16)f; return __builtin_bit_cast(unsigned short, b); }
__device__ __forceinline__ float bf2f(bf16_t b) { return __uint_as_float(((unsigned)b) << 16); }
typedef __bf16 bf2_t __attribute__((ext_vector_type(2)));
typedef float f2_t __attribute__((ext_vector_type(2)));
__device__ __forceinline__ unsigned pk2(float lo, float hi) { const f2_t v = {lo, hi}; const bf2_t b = __builtin_convertvector(v, bf2_t); return __builtin_bit_cast(unsigned, b); }
__device__ __forceinline__ float frcp(float x) { return __builtin_amdgcn_rcpf(x); }
__device__ __forceinline__ float fexp(float x) { return __builtin_amdgcn_exp2f(x * 1.4426950408889634f); }
__device__ __forceinline__ float sigmoidf_(float x) { return frcp(1.0f + __builtin_amdgcn_exp2f(x * -1.4426950408889634f)); }
__device__ __forceinline__ int otid() { int t = threadIdx.x; asm volatile("" : "+v"(t)); return t; }
#define LDS_BAR() asm volatile("s_waitcnt lgkmcnt(0)\n\ts_barrier" ::: "memory")
#define MFMA16(a, b, c) __builtin_amdgcn_mfma_f32_16x16x32_bf16((a), (b), (c), 0, 0, 0)

struct P {
    const float *x, *f1n, *f1w1, *f1w3, *f1w2, *mixn, *win, *convw, *mlbi, *mlbf, *mlgn;
    const float *kpe, *kw1, *kb1, *kw2, *vpe, *vw1, *vb1, *vw2, *wout, *f2n, *f2w1, *f2w3, *f2w2, *fnorm;
    float* out;
    bf16_t *Wup1, *Wdn1, *Wup2, *Wdn2, *Wint, *Woutt, *Wc1t;
    bf16_t *xb;
    bf16_t *big;
    bf16_t *A2;
    float *ssq;
    float *UV;
    float *b1f;
    bf16_t *KCb;
    bf16_t *qkc;
    unsigned *kmx;
    float *gat;
    unsigned *bar;
};

namespace pg8 {
constexpr int BM = 256, BK = 64, HALF = 128, HTB = HALF * BK * 2, STAGE_BYTES = 8 * HTB, NXCD = 8, WGM = 8;
__host__ __device__ __forceinline__ int lds_byte(int r, int c) { const int st = (r >> 4) * 2 + (c >> 5), rr = r & 15, cc = c & 31, ob = rr * 64 + cc * 2; return st * 1024 + (ob ^ (((ob >> 9) & 1) << 5)); }
__host__ __device__ __forceinline__ void stage_rc(int b, int& R, int& C) { const int st = b / 1024, sb = b % 1024, swz = sb ^ (((sb >> 9) & 1) << 5); R = (st >> 1) * 16 + swz / 64; C = (st & 1) * 32 + (swz % 64) / 2; }
__host__ __device__ __forceinline__ int perm32(int rho) { const int n = rho >> 4, i = rho & 15; return 8 * (i >> 2) + 4 * n + (i & 3); }

struct Unit { int pm, pn, z; const char* a; const char* b; };
struct Dims { int K, lda, kstepA; };

struct Order {
    int nM, nN, nZ, G, c;
    const char* A; const char* Bt; size_t a_tile, b_tile, az0, az1, bz1;
    __device__ bool next(int i, Unit& u) const {
        const long L = (long)i * G + c; const int per = nM * nN;
        if (L >= (long)per * nZ) return false;
        int z = (int)(L / per); int wgid = (int)(L % per);
        { const int nwg = per, q = nwg / NXCD, r = nwg % NXCD, xcd = wgid % NXCD, off = wgid / NXCD; wgid = (xcd < r ? xcd * (q + 1) : r * (q + 1) + (xcd - r) * q) + off; }
        const int nig = WGM * nN, gid = wgid / nig, fm = gid * WGM, gsz = (nM - fm) < WGM ? (nM - fm) : WGM;
        u.pm = fm + ((wgid % nig) % gsz); u.pn = (wgid % nig) / gsz; u.z = z;
        u.a = A + (size_t)(z & 1) * az0 + (size_t)(z >> 1) * az1 + (size_t)u.pm * a_tile;
        u.b = Bt + (size_t)(z >> 1) * bz1 + (size_t)u.pn * b_tile;
        return true;
    }
};

template <class Epi, bool TOUCH = false>
__device__ __forceinline__ void gemm_phase(LAS unsigned char* lds, const Dims g, const Order& S, const Epi& E) {
    const int tid = otid(), wid = __builtin_amdgcn_readfirstlane(tid >> 6), lane = tid & 63, wr = wid >> 2, wc = wid & 3, fr = lane & 15, fq = lane >> 4;
    const int K = g.K, nt = K / BK;
    unsigned voffA[2], voffB[2];
#pragma unroll
    for (int i = 0; i < 2; ++i) { int R, C; stage_rc(tid * 16 + i * 8192, R, C); const int Rb = Epi::PERM ? ((R & ~31) + perm32(R & 31)) : R;
        voffA[i] = (unsigned)(R * g.lda + C) * 2u; voffB[i] = (unsigned)(Rb * K + C) * 2u; }
    const size_t kstepA = (size_t)g.kstepA * 2, kstepB = (size_t)(BK * 2);
    const size_t hstepA = (size_t)HALF * g.lda * 2, hstepB = (size_t)HALF * K * 2;
    const unsigned ldsw = (unsigned)wid * 1024u;
    const int aoff = lds_byte(wr * 64 + fr, fq * 8), boff = lds_byte(wc * 32 + fr, fq * 8);
#define PG8_SA(b, h) (((b) * 2 + (h)) * HTB)
#define PG8_SB(b, h) ((4 + (b) * 2 + (h)) * HTB)
#define PG8_STAGE(bufoff, gbase, voff) do { _Pragma("unroll") for (int _i = 0; _i < 2; ++_i) \
        __builtin_amdgcn_global_load_lds((const unsigned*)((const char*)(gbase) + (voff)[_i]), (LAS unsigned*)(lds + (bufoff) + ldsw + _i * 8192), 16, 0, 0); } while (0)
#define PG8_LDA(dst, b, h) do { _Pragma("unroll") for (int m = 0; m < 4; ++m) _Pragma("unroll") for (int k = 0; k < 2; ++k) dst[m][k] = *(const LAS bf16x8*)(lds + PG8_SA(b, h) + aoff + m * 2048 + k * 1024); } while (0)
#define PG8_LDB(dst, b, h) do { _Pragma("unroll") for (int n = 0; n < 2; ++n) _Pragma("unroll") for (int k = 0; k < 2; ++k) dst[n][k] = *(const LAS bf16x8*)(lds + PG8_SB(b, h) + boff + n * 2048 + k * 1024); } while (0)
#define PG8_MMA(ai, bj, At, Bt) do { __builtin_amdgcn_s_setprio(1); _Pragma("unroll") for (int m = 0; m < 4; ++m) _Pragma("unroll") for (int n = 0; n < 2; ++n) _Pragma("unroll") for (int k = 0; k < 2; ++k) \
        acc[ai][bj][m][n] = __builtin_amdgcn_mfma_f32_16x16x32_bf16(Bt[n][k], At[m][k], acc[ai][bj][m][n], 0, 0, 0); __builtin_amdgcn_s_setprio(0); } while (0)
#define PG8_WAIT_V(n) asm volatile("s_waitcnt vmcnt(" #n ")" ::: "memory")
#define PG8_WAIT_L(n) asm volatile("s_waitcnt lgkmcnt(" #n ")" ::: "memory")
#define PG8_BAR __builtin_amdgcn_s_barrier()
#define PG8_SCHED __builtin_amdgcn_sched_barrier(0)
    constexpr int TOUCH_D = 6;
#define PG8_TOUCH(reg, tt) do { const int _tt = (tt); const char* _sb = (_tt < nt) ? cA + (size_t)_tt * kstepA : (has_next ? nA + (size_t)(_tt - nt) * kstepA : cA); \
        const char* _p = _sb + (cur.pn & 3) * 8192 + (wid * 8 + (lane >> 3)) * 128; asm volatile("global_load_dword %0, %1, off" : "=v"(reg) : "v"(_p) : "memory"); } while (0)
    unsigned tchA = 0u, tchB = 0u;
    Unit cur, nxt; int ui = 0;
    if (!S.next(0, cur)) return;
    f32x4 acc[2][2][4][2];
#pragma unroll
    for (int a = 0; a < 2; ++a)
#pragma unroll
        for (int b = 0; b < 2; ++b)
#pragma unroll
            for (int m = 0; m < 4; ++m)
#pragma unroll
                for (int n = 0; n < 2; ++n) acc[a][b][m][n] = (f32x4){0.f, 0.f, 0.f, 0.f};
    bf16x8 At[4][2], B0[2][2], B1[2][2];
    const char* cA = cur.a; const char* cB = cur.b;
    PG8_STAGE(PG8_SB(0, 0), cB, voffB); PG8_STAGE(PG8_SB(0, 1), cB + hstepB, voffB); PG8_STAGE(PG8_SA(0, 0), cA, voffA); PG8_STAGE(PG8_SA(0, 1), cA + hstepA, voffA);
    if (wr == 1) PG8_BAR;
    PG8_WAIT_V(2); PG8_BAR;
    PG8_STAGE(PG8_SB(1, 0), cB + kstepB, voffB); PG8_STAGE(PG8_SA(1, 0), cA + kstepA, voffA); PG8_STAGE(PG8_SB(1, 1), cB + hstepB + kstepB, voffB);
    PG8_WAIT_V(6); PG8_BAR;
    for (;;) {
        const bool has_next = S.next(ui + 1, nxt);
        const char* nA = has_next ? nxt.a : cA; const char* nB = has_next ? nxt.b : cB;
        for (int t = 0; t < nt; t += 2) {
            const bool last = (t == nt - 2);
            const char* a1 = cA + (size_t)(t + 1) * kstepA;
            const char* a2 = last ? nA : cA + (size_t)(t + 2) * kstepA; const char* b2 = last ? nB : cB + (size_t)(t + 2) * kstepB;
            const char* a3 = a2 + kstepA; const char* b3 = b2 + kstepB;
            PG8_LDB(B0, 0, 0); PG8_LDB(B1, 0, 1); PG8_SCHED; PG8_LDA(At, 0, 0); PG8_STAGE(PG8_SA(1, 1), a1 + hstepA, voffA);
            if constexpr (TOUCH) { PG8_TOUCH(tchA, t + TOUCH_D); PG8_WAIT_V(9); asm volatile("" :: "v"(tchB)); } else PG8_WAIT_V(8);
            PG8_WAIT_L(0); PG8_BAR; PG8_MMA(0, 0, At, B0); PG8_MMA(0, 1, At, B1); PG8_BAR; PG8_SCHED;
            PG8_LDA(At, 0, 1); PG8_STAGE(PG8_SB(0, 0), b2, voffB); PG8_STAGE(PG8_SB(0, 1), b2 + hstepB, voffB); PG8_STAGE(PG8_SA(0, 0), a2, voffA);
            if constexpr (TOUCH) PG8_WAIT_V(9); else PG8_WAIT_V(8);
            PG8_WAIT_L(0); PG8_BAR; PG8_MMA(1, 0, At, B0); PG8_MMA(1, 1, At, B1); PG8_BAR; PG8_SCHED;
            PG8_LDB(B0, 1, 0); PG8_LDB(B1, 1, 1); PG8_SCHED; PG8_LDA(At, 1, 0); PG8_STAGE(PG8_SA(0, 1), a2 + hstepA, voffA);
            if constexpr (TOUCH) { PG8_TOUCH(tchB, t + 1 + TOUCH_D); PG8_WAIT_V(9); asm volatile("" :: "v"(tchA)); } else PG8_WAIT_V(8);
            PG8_WAIT_L(0); PG8_BAR; PG8_MMA(0, 0, At, B0); PG8_MMA(0, 1, At, B1); PG8_BAR; PG8_SCHED;
            PG8_LDA(At, 1, 1); PG8_STAGE(PG8_SB(1, 0), b3, voffB); PG8_STAGE(PG8_SB(1, 1), b3 + hstepB, voffB); PG8_STAGE(PG8_SA(1, 0), a3, voffA);
            if constexpr (TOUCH) PG8_WAIT_V(9); else PG8_WAIT_V(8);
            PG8_WAIT_L(0); PG8_BAR; PG8_MMA(1, 0, At, B0); PG8_MMA(1, 1, At, B1); PG8_BAR; PG8_SCHED;
        }
        if constexpr (TOUCH) { PG8_WAIT_V(6); asm volatile("" :: "v"(tchA), "v"(tchB)); }
        if (wr == 0) PG8_BAR;
        E(acc, cur, wr, wc, fr, fq);
        if (!has_next) break;
#pragma unroll
        for (int a = 0; a < 2; ++a)
#pragma unroll
            for (int b = 0; b < 2; ++b)
#pragma unroll
                for (int m = 0; m < 4; ++m)
#pragma unroll
                    for (int n = 0; n < 2; ++n) acc[a][b][m][n] = (f32x4){0.f, 0.f, 0.f, 0.f};
        cur = nxt; cA = nA; cB = nB; ++ui;
        if (wr == 1) PG8_BAR;
    }
    PG8_WAIT_V(0);
    PG8_BAR;
#undef PG8_SA
#undef PG8_SB
#undef PG8_STAGE
#undef PG8_LDA
#undef PG8_LDB
#undef PG8_MMA
#undef PG8_WAIT_V
#undef PG8_WAIT_L
#undef PG8_BAR
#undef PG8_SCHED
#undef PG8_TOUCH
}
}

struct EpiUp {
    static constexpr bool PERM = true;
    bf16_t* H; const float* ssq;
    __device__ __forceinline__ void operator()(const f32x4 (&acc)[2][2][4][2], const pg8::Unit& u, int wr, int wc, int fr, int fq) const {
#pragma unroll
        for (int ai = 0; ai < 2; ++ai)
#pragma unroll
            for (int m = 0; m < 4; ++m) {
                const int row = u.pm * 256 + ai * 128 + wr * 64 + m * 16 + fr;
                const float rs = rsqrtf(ssq[row] * (1.0f / DM) + EPS);
                float hv[8];
#pragma unroll
                for (int n = 0; n < 2; ++n)
#pragma unroll
                    for (int i = 0; i < 4; ++i) { const float a = acc[ai][0][m][n][i] * rs, b = acc[ai][1][m][n][i] * rs; hv[n * 4 + i] = a * sigmoidf_(a) * b; }
                u32x4 w; w.x = pk2(hv[0], hv[1]); w.y = pk2(hv[2], hv[3]); w.z = pk2(hv[4], hv[5]); w.w = pk2(hv[6], hv[7]);
                { const int r = ai * 128 + wr * 64 + m * 16 + fr, kt = 2 * u.pn + (wc >> 1), cc = (wc & 1) * 32 + fq * 8;
                  __builtin_nontemporal_store(w, (u32x4*)(H + ((size_t)(u.pm * 44 + kt) * 256 + r) * 64 + cc)); }
            }
    }
};
struct EpiRes {
    static constexpr bool PERM = true;
    const float* resid_f; bf16_t* xb; float* ssq; float scale;
    __device__ __forceinline__ void operator()(const f32x4 (&acc)[2][2][4][2], const pg8::Unit& u, int wr, int wc, int fr, int fq) const {
#pragma unroll
        for (int ai = 0; ai < 2; ++ai) {
            u32x4 r[4][2];
#pragma unroll
            for (int m = 0; m < 4; ++m) { const size_t off = (size_t)(u.pm * 256 + ai * 128 + wr * 64 + m * 16 + fr) * DM + u.pn * 256 + wc * 32 + fq * 8;
#pragma unroll
                for (int bj = 0; bj < 2; ++bj) r[m][bj] = *(const u32x4*)(xb + off + bj * 128); }
            float ss[4];
#pragma unroll
            for (int m = 0; m < 4; ++m) { const size_t off = (size_t)(u.pm * 256 + ai * 128 + wr * 64 + m * 16 + fr) * DM + u.pn * 256 + wc * 32 + fq * 8;
                float s = 0.f;
#pragma unroll
                for (int bj = 0; bj < 2; ++bj) {
                    u32x4 w;
#pragma unroll
                    for (int n = 0; n < 2; ++n) { const unsigned bx = r[m][bj][2 * n], by = r[m][bj][2 * n + 1]; f32x4 rv;
                        rv[0] = __uint_as_float(bx << 16); rv[1] = __uint_as_float(bx & 0xffff0000u); rv[2] = __uint_as_float(by << 16); rv[3] = __uint_as_float(by & 0xffff0000u);
                        const f32x4 v = rv + acc[ai][bj][m][n] * scale;
                        w[2 * n] = pk2(v[0], v[1]); w[2 * n + 1] = pk2(v[2], v[3]);
                        s += (v[0] * v[0] + v[1] * v[1]) + (v[2] * v[2] + v[3] * v[3]); }
                    *(u32x4*)(xb + off + bj * 128) = w; }
                s += __shfl_xor(s, 16); s += __shfl_xor(s, 32); ss[m] = s; }
            if (fq == 0) {
#pragma unroll
                for (int m = 0; m < 4; ++m) atomicAdd(ssq + u.pm * 256 + ai * 128 + wr * 64 + m * 16 + fr, ss[m]); }
        }
    }
};
struct EpiProj {
    static constexpr bool PERM = true;
    bf16_t* O; const float* ssq;
    __device__ __forceinline__ void operator()(const f32x4 (&acc)[2][2][4][2], const pg8::Unit& u, int wr, int wc, int fr, int fq) const {
#pragma unroll
        for (int ai = 0; ai < 2; ++ai)
#pragma unroll
            for (int m = 0; m < 4; ++m) {
                const int row = u.pm * 256 + ai * 128 + wr * 64 + m * 16 + fr;
                const float rs = rsqrtf(ssq[row] * (1.0f / DM) + EPS);
#pragma unroll
                for (int bj = 0; bj < 2; ++bj) {
                    const f32x4 v0 = acc[ai][bj][m][0] * rs, v1 = acc[ai][bj][m][1] * rs;
                    u32x4 w; w.x = pk2(v0[0], v0[1]); w.y = pk2(v0[2], v0[3]); w.z = pk2(v1[0], v1[1]); w.w = pk2(v1[2], v1[3]);
                    if (u.pn * 256 + bj * 128 + wc * 32 + fq * 8 < 3360)
                        __builtin_nontemporal_store(w, (u32x4*)(O + (size_t)row * LDP + u.pn * 256 + bj * 128 + wc * 32 + fq * 8));
                }
            }
    }
};
struct EpiUV {
    static constexpr bool PERM = false;
    float* UV;
    __device__ __forceinline__ void operator()(const f32x4 (&acc)[2][2][4][2], const pg8::Unit& u, int wr, int wc, int fr, int fq) const {
#pragma unroll
        for (int ai = 0; ai < 2; ++ai)
#pragma unroll
            for (int m = 0; m < 4; ++m) {
                const int row = u.pm * 256 + ai * 128 + wr * 64 + m * 16 + fr;
                float* rp = UV + ((size_t)u.z * 2048 + row) * 512 + u.pn * 256 + wc * 32 + fq * 4;
#pragma unroll
                for (int bj = 0; bj < 2; ++bj)
#pragma unroll
                    for (int n = 0; n < 2; ++n) *(f32x4*)(rp + bj * 128 + n * 16) = acc[ai][bj][m][n];
            }
    }
};

__device__ __forceinline__ int rowmap(int mode, int j) {
    if (mode == 1) return ((j >> 7) << 8) + (j & 127);
    if (mode == 2) return ((j >> 7) << 8) + 128 + (j & 127);
    if (mode == 3) { if (j < 2048) return j; if (j < 2056) return 3328 + (j - 2048); if (j < 3336) return j - 8; return j; }
    return j;
}
__device__ __forceinline__ void transpose_item(const float* W, int N, int k0, int n0, const float* gain, bf16_t* Bt, int Kdst, int kd0, int rowoff, int mode, LAS float* scr, int lane) {
    const int n4 = (lane & 7) * 4, kr = lane >> 3;
    f32x4 v[8];
#pragma unroll
    for (int i = 0; i < 8; ++i) v[i] = __builtin_nontemporal_load((const f32x4*)(W + (size_t)(k0 + i * 8 + kr) * N + n0 + n4));
    if (gain) {
#pragma unroll
        for (int i = 0; i < 8; ++i) v[i] = v[i] * gain[k0 + i * 8 + kr]; }
#pragma unroll
    for (int i = 0; i < 8; ++i) { LAS float* d = scr + (i * 8 + kr) * 33 + n4; d[0] = v[i][0]; d[1] = v[i][1]; d[2] = v[i][2]; d[3] = v[i][3]; }
    asm volatile("s_waitcnt lgkmcnt(0)" ::: "memory");
    const int c = lane & 7;
#pragma unroll
    for (int j = 0; j < 4; ++j) { const int n = (lane >> 3) + 8 * j; const LAS float* q = scr + (8 * c) * 33 + n;
        u32x4 o; o.x = pk2(q[0], q[33]); o.y = pk2(q[2 * 33], q[3 * 33]); o.z = pk2(q[4 * 33], q[5 * 33]); o.w = pk2(q[6 * 33], q[7 * 33]);
        *(u32x4*)(Bt + (size_t)(rowmap(mode, n0 + n) + rowoff) * Kdst + kd0 + 8 * c) = o; }
    asm volatile("s_waitcnt lgkmcnt(0)" ::: "memory");
}
__device__ __forceinline__ float wave_sum(float v) {
#pragma unroll
    for (int o = 1; o < 64; o <<= 1) v += __shfl_xor(v, o);
    return v;
}
__device__ __forceinline__ void phase_prep_late(const P& p, LAS unsigned char* lds, int widx, int wcnt, int it_lo, int it_hi) {
    const int tid = otid();
    LAS float* scr = (LAS float*)lds + (tid >> 6) * (64 * 33);
    const int lane_ = tid & 63, gw_ = widx * 8 + (tid >> 6), NGW_ = wcnt * 8;
    constexpr int I_UP = 16 * 88, I_DN = 44 * 32, I_OUT = 16 * 32;
    constexpr int NIT = (2 * I_UP + I_DN) + I_OUT;
    if (it_hi > NIT) it_hi = NIT;
    __syncthreads();
    for (int it = it_lo + gw_; it < it_hi; it += NGW_) {
        int r = it;
        if (r < I_UP) { transpose_item(p.f2w1, FF, (r / 88) * 64, (r % 88) * 32, p.f2n, p.Wup2, DM, (r / 88) * 64, 0, 1, scr, lane_); continue; } r -= I_UP;
        if (r < I_UP) { transpose_item(p.f2w3, FF, (r / 88) * 64, (r % 88) * 32, p.f2n, p.Wup2, DM, (r / 88) * 64, 0, 2, scr, lane_); continue; } r -= I_UP;
        if (r < I_DN) { transpose_item(p.f2w2, DM, (r / 32) * 64, (r % 32) * 32, nullptr, p.Wdn2, FF, (r / 32) * 64, 0, 0, scr, lane_); continue; } r -= I_DN;
        transpose_item(p.wout, DM, (r / 32) * 64, (r % 32) * 32, nullptr, p.Woutt, DM, (r / 32) * 64, 0, 0, scr, lane_);
    }
    __syncthreads();
}
__device__ __forceinline__ void phase_prep(const P& p, LAS unsigned char* lds) {
    const int G = gridDim.x, c = blockIdx.x, tid = otid();
    LAS float* scr = (LAS float*)lds + (tid >> 6) * (64 * 33);
    const int lane_ = tid & 63, gw_ = c * 8 + (tid >> 6), NGW_ = G * 8;
    constexpr int I_UP = 16 * 88, I_DN = 44 * 32, I_IN = 16 * 105, I_C = 32 * 8;
    constexpr int NIT = (2 * I_UP + I_DN) + I_IN + 2 * I_C;
    for (int it = gw_; it < NIT; it += NGW_) {
        int r = it;
        if (r < I_UP) { transpose_item(p.f1w1, FF, (r / 88) * 64, (r % 88) * 32, p.f1n, p.Wup1, DM, (r / 88) * 64, 0, 1, scr, lane_); continue; } r -= I_UP;
        if (r < I_UP) { transpose_item(p.f1w3, FF, (r / 88) * 64, (r % 88) * 32, p.f1n, p.Wup1, DM, (r / 88) * 64, 0, 2, scr, lane_); continue; } r -= I_UP;
        if (r < I_DN) { transpose_item(p.f1w2, DM, (r / 32) * 64, (r % 32) * 32, nullptr, p.Wdn1, FF, (r / 32) * 64, 0, 0, scr, lane_); continue; } r -= I_DN;
        if (r < I_IN) { transpose_item(p.win, 3360, (r / 105) * 64, (r % 105) * 32, p.mixn, p.Wint, DM, (r / 105) * 64, 0, 3, scr, lane_); continue; } r -= I_IN;
        { const int which = r / I_C; r %= I_C; const int k0 = (r / 8) * 64, n0 = (r % 8) * 32;
          transpose_item(which ? p.vw1 : p.kw1, 256, k0, n0, nullptr, p.Wc1t + (size_t)which * 512 * 1024, 1024, k0 & 1023, (k0 >> 10) * 256, 0, scr, lane_); }
    }
    { u32x4 z = {0u, 0u, 0u, 0u}; u32x4* dst = (u32x4*)(p.Wint + (size_t)3360 * DM); const int n16 = 224 * DM / 8;
      for (int i = c * 512 + tid; i < n16; i += G * 512) dst[i] = z; }
    for (int i = c * 512 + tid; i < 3 * MTOK; i += G * 512) p.ssq[MTOK + i] = 0.f;
    if (c == 0 && tid < 64) p.kmx[tid] = 0u;
    { const int lane = tid & 63, gw = c * 8 + (tid >> 6), NGW = G * 8;
      for (int row0 = gw; row0 < MTOK; row0 += 4 * NGW) {
          f32x4 v[4][4];
#pragma unroll
          for (int r = 0; r < 4; ++r) { const int row = row0 + r * NGW; if (row < MTOK) { const f32x4* xr = (const f32x4*)(p.x + (size_t)row * DM) + lane;
#pragma unroll
              for (int j = 0; j < 4; ++j) v[r][j] = __builtin_nontemporal_load(xr + 64 * j); } }
#pragma unroll
          for (int r = 0; r < 4; ++r) { const int row = row0 + r * NGW; if (row < MTOK) { u32x2* o = (u32x2*)(p.xb + (size_t)row * DM) + lane; float s = 0.f;
#pragma unroll
              for (int j = 0; j < 4; ++j) { const f32x4 t = v[r][j]; s += (t[0] * t[0] + t[1] * t[1]) + (t[2] * t[2] + t[3] * t[3]); u32x2 w; w.x = pk2(t[0], t[1]); w.y = pk2(t[2], t[3]); o[64 * j] = w; }
              s = wave_sum(s); if (lane == 0) p.ssq[row] = s; } } } }
    if (c < 8) {
        LAS float* scr = (LAS float*)lds;
        __syncthreads();
        const int which = c >> 2, col = (c & 3) * 64 + (tid & 63), part = tid >> 6;
        const float* pe = which ? p.vpe : p.kpe; const float* w1 = which ? p.vw1 : p.kw1; const float* b1 = which ? p.vb1 : p.kb1;
        float s = 0.f;
        for (int k = part * 256; k < part * 256 + 256; ++k) s += pe[k] * w1[(size_t)k * 256 + col];
        scr[part * 64 + (tid & 63)] = s;
        __syncthreads();
        if (tid < 64) { float t = b1[col]; for (int q = 0; q < 8; ++q) t += scr[q * 64 + tid]; p.b1f[which * 256 + col] = t; }
        __syncthreads();
    }
}

__device__ __forceinline__ void phase_cmp2(const P& p, LAS unsigned char* lds) {
    const int tid = otid(), lane = tid & 63, w = tid >> 6;
    LAS bf16_t* w2s = (LAS bf16_t*)lds;
    LAS float* zs = (LAS float*)(lds + 65536) + w * 256;
    const int gw = blockIdx.x * 8 + w, NGW = gridDim.x * 8;
    __syncthreads();
    for (int r0 = gw; r0 < 2 * 4096; r0 += 4 * NGW) {
        float zin[4][4];
#pragma unroll
        for (int i = 0; i < 4; ++i) { const int r = r0 + i * NGW;
            if (r < 2 * 4096) { const int which = r >> 12, n = r & 127, g = (r >> 7) & 1, b = (r >> 8) & 15;
                const float* U = p.UV + ((size_t)(which * 2 + g) * 2048 + b * 128 + (n == 127 ? 126 : n)) * 512;
#pragma unroll
                for (int k = 0; k < 4; ++k) { const int cc = lane + 64 * k; zin[i][k] = U[cc] + U[512 + 256 + cc] + p.b1f[which * 256 + cc]; } } }
        if (r0 == gw) {
            for (int i = tid; i < 2 * 256 * 64 / 4; i += 512) { const f32x4 v = (i < 4096) ? *(const f32x4*)(p.kw2 + 4 * i) : *(const f32x4*)(p.vw2 + 4 * (i - 4096));
                u32x2 o; o.x = pk2(v[0], v[1]); o.y = pk2(v[2], v[3]); *(LAS u32x2*)(w2s + 4 * i) = o; }
            __syncthreads();
        }
#pragma unroll
        for (int i = 0; i < 4; ++i) { const int r = r0 + i * NGW;
            if (r < 2 * 4096) { const int which = r >> 12, n = r & 127;
                bf16_t* dst = p.KCb + (size_t)r * 64;
                if (n == 127) { dst[lane] = 0; }
                else {
#pragma unroll
                    for (int k = 0; k < 4; ++k) { const float z = zin[i][k]; zs[lane + 64 * k] = z * sigmoidf_(z); }
                    asm volatile("s_waitcnt lgkmcnt(0)" ::: "memory");
                    const LAS bf16_t* wm = w2s + which * (256 * 64);
                    float s0 = 0.f, s1 = 0.f, s2 = 0.f, s3 = 0.f;
#pragma unroll 8
                    for (int k = 0; k < 256; k += 4) { const f32x4 z4 = *(const LAS f32x4*)(zs + k);
                        s0 += z4[0] * bf2f(wm[(k + 0) * 64 + lane]); s1 += z4[1] * bf2f(wm[(k + 1) * 64 + lane]); s2 += z4[2] * bf2f(wm[(k + 2) * 64 + lane]); s3 += z4[3] * bf2f(wm[(k + 3) * 64 + lane]); }
                    dst[lane] = f2bf((s0 + s1) + (s2 + s3));
                    asm volatile("s_waitcnt lgkmcnt(0)" ::: "memory");
                } } }
    }
    __syncthreads();
}

__device__ __forceinline__ void phase_conv(const P& p, int widx, int wcnt) {
    const int tid = otid(); const int cg8 = (tid & 127) * 8, seg = tid >> 7;
    const bf16_t* proj = p.big;
    float cw[4][8];
#pragma unroll
    for (int j = 0; j < 4; ++j)
#pragma unroll
        for (int i = 0; i < 8; ++i) cw[j][i] = p.convw[j * 1024 + cg8 + i];
    const float osc = (cg8 < 512) ? 0.08838834764831845f : 1.0f;
    for (int item = widx; item < MTOK / 64; item += wcnt) {
        const int tok0 = item * 64 + seg * 16; const int tin = tok0 & (TSEQ - 1);
        float x0[8], x1[8], x2[8];
#define CV_UNPACK(dst, r) do { _Pragma("unroll") for (int e = 0; e < 4; ++e) { dst[2 * e] = __uint_as_float((r)[e] << 16); dst[2 * e + 1] = __uint_as_float((r)[e] & 0xffff0000u); } } while (0)
        { const u32x4 z = {0u, 0u, 0u, 0u};
          const u32x4 r0 = (tin >= 3) ? *(const u32x4*)(proj + (size_t)(tok0 - 3) * LDP + cg8) : z;
          const u32x4 r1 = (tin >= 2) ? *(const u32x4*)(proj + (size_t)(tok0 - 2) * LDP + cg8) : z;
          const u32x4 r2 = (tin >= 1) ? *(const u32x4*)(proj + (size_t)(tok0 - 1) * LDP + cg8) : z;
          CV_UNPACK(x0, r0); CV_UNPACK(x1, r1); CV_UNPACK(x2, r2); }
        u32x4 rr[16];
#pragma unroll
        for (int t = 0; t < 16; ++t) rr[t] = __builtin_nontemporal_load((const u32x4*)(proj + (size_t)(tok0 + t) * LDP + cg8));
#pragma unroll
        for (int t = 0; t < 16; ++t) {
            float x3[8], y[8]; CV_UNPACK(x3, rr[t]);
#pragma unroll
            for (int ch = 0; ch < 8; ++ch) {
                const float v = (cw[0][ch] * x0[ch] + cw[1][ch] * x1[ch]) + (cw[2][ch] * x2[ch] + cw[3][ch] * x3[ch]);
                y[ch] = v * sigmoidf_(v) * osc; x0[ch] = x1[ch]; x1[ch] = x2[ch]; x2[ch] = x3[ch]; }
            u32x4 o; o.x = pk2(y[0], y[1]); o.y = pk2(y[2], y[3]); o.z = pk2(y[4], y[5]); o.w = pk2(y[6], y[7]);
            *(u32x4*)(p.qkc + (size_t)(tok0 + t) * DM + cg8) = o;
        }
#undef CV_UNPACK
    }
}

__device__ __forceinline__ void phase_gates(const P& p, int widx, int wcnt) {
    const int tid = otid(), lane = tid & 63; const int gw = widx * 8 + (tid >> 6), NGW = wcnt * 8;
    const bf16_t* proj = p.big;
    for (int task = gw; task < 16 * 4 * 32; task += NGW) {
        const int c = task & 31, h = (task >> 5) & 3, b = task >> 7;
        const size_t tok = (size_t)b * TSEQ + c * 64 + lane;
        const float fpre = bf2f(proj[tok * LDP + C_GF + h]) + p.mlbf[h];
        const float li = bf2f(proj[tok * LDP + C_GI + h]) + p.mlbi[h];
        const float lf = fminf(fpre, 0.f) - log1pf(fexp(-fabsf(fpre)));
        float bb = lf;
#pragma unroll
        for (int o = 1; o < 64; o <<= 1) { const float t = __shfl_up(bb, o); if (lane >= o) bb += t; }
        const float u = li - bb; float pmx = u;
#pragma unroll
        for (int o = 1; o < 64; o <<= 1) { const float t = __shfl_up(pmx, o); if (lane >= o) pmx = fmaxf(pmx, t); }
        *(f32x4*)(p.gat + ((size_t)(b * 4 + h) * TSEQ + c * 64 + lane) * 4) = (f32x4){bb, u, pmx, 0.f};
    }
}

__device__ __forceinline__ void phase_kmax(const P& p, int widx, int wcnt) {
    const int tid = otid(), lane = tid & 63; const int gw = widx * 8 + (tid >> 6), NGW = wcnt * 8;
    const bf16_t* proj = p.big;
    for (int task = gw; task < 64 * 4; task += NGW) {
        const int qd = task & 3, id = task >> 2, br = id & 1, g = (id >> 1) & 1, b = id >> 2;
        const int col = (br ? C_KW : C_KS) + g * 64; float mx = 0.f;
        for (int i = 0; i < 8; ++i) { const size_t tok = (size_t)b * TSEQ + qd * 512 + i * 64 + lane; float s2 = 0.f;
#pragma unroll
            for (int c8 = 0; c8 < 8; ++c8) { const u32x4 kv = *(const u32x4*)(proj + tok * LDP + col + c8 * 8);
#pragma unroll
                for (int e = 0; e < 4; ++e) { const float lo = __uint_as_float(kv[e] << 16), hi = __uint_as_float(kv[e] & 0xffff0000u); s2 += lo * lo + hi * hi; } }
            mx = fmaxf(mx, s2); }
#pragma unroll
        for (int o = 1; o < 64; o <<= 1) mx = fmaxf(mx, __shfl_xor(mx, o));
        if (lane == 0) atomicMax(p.kmx + id, __float_as_uint(mx));
    }
}

__device__ __forceinline__ f32x4 mma_tile(const LAS bf16_t* A, int lda, const LAS bf16_t* Bt, int ldb, int K, f32x4 acc, int lane) {
    const LAS bf16_t* pa = A + (lane & 15) * lda + (lane >> 4) * 8; const LAS bf16_t* pb = Bt + (lane & 15) * ldb + (lane >> 4) * 8;
    for (int k = 0; k < K; k += 32) { const bf16x8 a = *(const LAS bf16x8*)(pa + k); const bf16x8 b = *(const LAS bf16x8*)(pb + k); acc = MFMA16(a, b, acc); }
    return acc;
}
__device__ __forceinline__ void mlstm_unit(const P& p, LAS unsigned char* lds, int unit) {
    const int tid = otid(), lane = tid & 63, w = tid >> 6, q4 = lane >> 4, r16 = lane & 15;
    const int dvs = unit & 3, h = (unit >> 2) & 3, b = unit >> 4;
    LAS bf16_t* Qs = (LAS bf16_t*)lds;
    LAS bf16_t* Ks = Qs + 64 * 136;
    LAS bf16_t* KTs = Ks + 64 * 136;
    LAS bf16_t* VT0 = KTs + 128 * 72;
    LAS bf16_t* Cs = VT0 + 2 * 48 * 72;
    LAS bf16_t* Ss = Cs + 48 * 136;
    LAS float* gl0 = (LAS float*)(Ss + 64 * 72);
    const bf16_t* proj = p.big;
    __syncthreads();
    for (int i = tid; i < 16 * 72; i += 512) { VT0[32 * 72 + i] = (bf16_t)0x3F80; VT0[48 * 72 + 32 * 72 + i] = (bf16_t)0x3F80; }
    for (int i = tid; i < 48 * 136; i += 512) Cs[i] = 0;
    f32x4 accC[3];
#pragma unroll
    for (int i = 0; i < 3; ++i) accC[i] = (f32x4){0.f, 0.f, 0.f, 0.f};
    float m_prev = 0.f, adec = 1.f;
    const bf16_t* qk = p.qkc;
    const int lt_ = tid & 63, cg16 = (tid >> 6) * 16;
    u32x4 qr[2], kr[2]; u32x2 vraw; f32x4 gv;
#define ML_LOAD(cc) do { const size_t _t = (size_t)(b * TSEQ + (cc) * 64 + lt_); \
        gv = *(const f32x4*)(p.gat + ((size_t)(b * 4 + h) * TSEQ + (cc) * 64 + lt_) * 4); \
        qr[0] = *(const u32x4*)(qk + _t * DM + h * 128 + cg16); qr[1] = *(const u32x4*)(qk + _t * DM + h * 128 + cg16 + 8); \
        kr[0] = *(const u32x4*)(qk + _t * DM + 512 + h * 128 + cg16); kr[1] = *(const u32x4*)(qk + _t * DM + 512 + h * 128 + cg16 + 8); \
        vraw = *(const u32x2*)(proj + _t * LDP + C_MV + h * 128 + dvs * 32 + (tid >> 6) * 4); } while (0)
#define ML_STAGE(cc) do { \
        const float bb = gv[0], u = gv[1], pmx = gv[2]; \
        const float gsum = __int_as_float(__builtin_amdgcn_readlane(__float_as_int(bb), 63)); \
        const float pmx63 = __int_as_float(__builtin_amdgcn_readlane(__float_as_int(pmx), 63)); \
        const float m_inter = bb + m_prev, mt = fmaxf(m_inter, bb + pmx), rr = fexp(m_inter - mt); \
        const float mloc = gsum + pmx63, m_new = fmaxf(gsum + m_prev, mloc); \
        adec = fexp(gsum + m_prev - m_new); \
        const float es = fexp(gsum + u - m_new), c1 = bb - mt, nd = fexp(-mt); \
        m_prev = m_new; \
        LAS float* gl = gl0 + ((cc) & 1) * 256; LAS bf16_t* VTs = VT0 + ((cc) & 1) * (48 * 72); \
        if (w == 0) { gl[lane] = c1; gl[64 + lane] = u; gl[128 + lane] = rr; gl[192 + lane] = nd; } \
        *(LAS u32x4*)(Qs + lt_ * 136 + cg16) = qr[0]; *(LAS u32x4*)(Qs + lt_ * 136 + cg16 + 8) = qr[1]; \
        *(LAS u32x4*)(Ks + lt_ * 136 + cg16) = kr[0]; *(LAS u32x4*)(Ks + lt_ * 136 + cg16 + 8) = kr[1]; \
        _Pragma("unroll") for (int hf = 0; hf < 2; ++hf) \
            _Pragma("unroll") for (int e = 0; e < 4; ++e) { const unsigned wd = kr[hf][e]; const int ch = cg16 + hf * 8 + 2 * e; const int col = lt_ ^ ((((cg16 >> 3) + hf) & 7) << 3); \
                KTs[ch * 72 + col] = f2bf(__uint_as_float(wd << 16) * es); KTs[(ch + 1) * 72 + col] = f2bf(__uint_as_float(wd & 0xffff0000u) * es); } \
        { const int dv4 = (tid >> 6) * 4; \
          VTs[(dv4 + 0) * 72 + lt_] = (bf16_t)(vraw.x & 0xffffu); VTs[(dv4 + 1) * 72 + lt_] = (bf16_t)(vraw.x >> 16); \
          VTs[(dv4 + 2) * 72 + lt_] = (bf16_t)(vraw.y & 0xffffu); VTs[(dv4 + 3) * 72 + lt_] = (bf16_t)(vraw.y >> 16); } } while (0)
    ML_LOAD(0);
    ML_STAGE(0);
    ML_LOAD(1);
    float adec_cur = adec;
    for (int c = 0; c < 32; ++c) {
        const int tok0 = b * TSEQ + c * 64;
        LAS float* gl = gl0 + (c & 1) * 256; LAS bf16_t* VTs = VT0 + (c & 1) * (48 * 72);
        const int lt = w >> 1, dvt = w & 1; const f32x4 z4 = {0.f, 0.f, 0.f, 0.f};
        LDS_BAR();
#pragma unroll
        for (int sti = 0; sti < 2; ++sti) { const int st = (w & 1) * 2 + sti;
            f32x4 acc = {0.f, 0.f, 0.f, 0.f};
            if (st <= lt) acc = mma_tile(Qs + lt * 16 * 136, 136, Ks + st * 16 * 136, 136, 128, acc, lane);
            const int s = st * 16 + r16; const float us = gl[64 + s];
#pragma unroll
            for (int j = 0; j < 4; ++j) { const int l = lt * 16 + q4 * 4 + j; const float c1l = gl[l];
                const float d = (s <= l) ? fexp(c1l + us) : 0.f; Ss[l * 72 + s] = f2bf(acc[j] * d); } }
        const f32x4 nx = mma_tile(Cs + dvt * 16 * 136, 136, Qs + lt * 16 * 136, 136, 128, z4, lane);
        const f32x4 dx = mma_tile(Cs + 32 * 136, 136, Qs + lt * 16 * 136, 136, 128, z4, lane);
#pragma unroll
        for (int d3 = 0; d3 < 3; ++d3) { f32x4 acc = accC[d3] * adec_cur; const int gsw = ((2 * w + (r16 >> 3)) & 7) << 3;
#pragma unroll
            for (int ks = 0; ks < 2; ++ks) { const bf16x8 a = *(const LAS bf16x8*)(VTs + (d3 * 16 + r16) * 72 + ks * 32 + q4 * 8);
                const bf16x8 bb8 = *(const LAS bf16x8*)(KTs + (w * 16 + r16) * 72 + ((ks * 32 + q4 * 8) ^ gsw)); acc = MFMA16(a, bb8, acc); }
            accC[d3] = acc; }
        LDS_BAR();
        { const f32x4 ni = mma_tile(VTs + dvt * 16 * 72, 72, Ss + lt * 16 * 72, 72, 64, z4, lane);
          const f32x4 di = mma_tile(VTs + 32 * 72, 72, Ss + lt * 16 * 72, 72, 64, z4, lane);
          const int l = lt * 16 + r16; const float rl = gl[128 + l], ndl = gl[192 + l];
          float hv[4];
#pragma unroll
          for (int j = 0; j < 4; ++j) { const float den = di[j] + rl * dx[j]; hv[j] = (ni[j] + rl * nx[j]) * frcp(fmaxf(fabsf(den), ndl)); }
          u32x2 wv; wv.x = pk2(hv[0], hv[1]); wv.y = pk2(hv[2], hv[3]);
          *(u32x2*)(p.A2 + (size_t)(tok0 + l) * DM + h * 128 + dvs * 32 + dvt * 16 + q4 * 4) = wv; }
#pragma unroll
        for (int d3 = 0; d3 < 3; ++d3)
#pragma unroll
            for (int j = 0; j < 4; ++j) Cs[(d3 * 16 + q4 * 4 + j) * 136 + w * 16 + r16] = f2bf(accC[d3][j]);
        if (c + 1 < 32) { ML_STAGE(c + 1); adec_cur = adec; if (c + 2 < 32) ML_LOAD(c + 2); }
    }
#undef ML_LOAD
#undef ML_STAGE
}
__device__ __forceinline__ void phase_mlstm_fin(const P& p) {
    const int tid = otid(), lane = tid & 63; const int gw = blockIdx.x * 8 + (tid >> 6), NGW = gridDim.x * 8;
    float gn[8];
#pragma unroll
    for (int i = 0; i < 8; ++i) gn[i] = p.mlgn[lane * 8 + i];
    for (int tok0 = gw; tok0 < MTOK; tok0 += 4 * NGW) {
        u32x4 hv[4], ov[4];
#pragma unroll
        for (int r = 0; r < 4; ++r) { const int tok = tok0 + r * NGW; if (tok < MTOK) { hv[r] = *((const u32x4*)(p.A2 + (size_t)tok * DM) + lane); ov[r] = *((const u32x4*)(p.big + (size_t)tok * LDP + C_MO) + lane); } }
#pragma unroll
        for (int r = 0; r < 4; ++r) { const int tok = tok0 + r * NGW; if (tok < MTOK) {
            float v[8]; float s = 0.f;
#pragma unroll
            for (int i = 0; i < 4; ++i) { v[2 * i] = __uint_as_float(hv[r][i] << 16); v[2 * i + 1] = __uint_as_float(hv[r][i] & 0xffff0000u); s += v[2 * i] * v[2 * i] + v[2 * i + 1] * v[2 * i + 1]; }
            s += __shfl_xor(s, 1); s += __shfl_xor(s, 2); s += __shfl_xor(s, 4); s += __shfl_xor(s, 8);
            const float rs = rsqrtf(s * (1.0f / 128.0f) + EPS);
            float y[8];
#pragma unroll
            for (int i = 0; i < 8; ++i) { const float o = (i & 1) ? __uint_as_float(ov[r][i >> 1] & 0xffff0000u) : __uint_as_float(ov[r][i >> 1] << 16);
                y[i] = v[i] * rs * gn[i] * sigmoidf_(o); }
            u32x4 w; w.x = pk2(y[0], y[1]); w.y = pk2(y[2], y[3]); w.z = pk2(y[4], y[5]); w.w = pk2(y[6], y[7]);
            *((u32x4*)(p.A2 + (size_t)tok * DM) + lane) = w; } }
    }
}

template <int MODE, bool BND, bool FAST>
__device__ __forceinline__ void nsa_step(const LAS bf16_t* Kb, const LAS bf16_t* VbT, int j, int jt, int th, int q4, int r16, unsigned mk0, unsigned mk1,
                                         const bf16x8 (&bq)[2][2], f32x4 (&O)[4][2], float (&mrow)[2], float (&lrow)[2]) {
        bf16x8 pb[2][2];
#pragma unroll
        for (int rt = 0; rt < 2; ++rt) {
            f32x4 s[4];
#pragma unroll
            for (int kt = 0; kt < 4; ++kt) {
                const bf16x8 a0 = *(const LAS bf16x8*)(Kb + (kt * 16 + r16) * 72 + q4 * 8), a1 = *(const LAS bf16x8*)(Kb + (kt * 16 + r16) * 72 + 32 + q4 * 8);
                f32x4 acc = {0.f, 0.f, 0.f, 0.f}; acc = MFMA16(a0, bq[rt][0], acc); acc = MFMA16(a1, bq[rt][1], acc); s[kt] = acc;
            }
            const int t = jt * 64 + th * 32 + rt * 16 + r16; const unsigned mk = rt ? mk1 : mk0;
            const bool rowsel = (MODE == 0) ? (((mk >> j) & 1u) != 0u) : true;
            const float NINF = -__builtin_inff(), CS = 0.125f * 1.4426950408889634f;
            if (BND) {
#pragma unroll
                for (int kt = 0; kt < 4; ++kt)
#pragma unroll
                    for (int i = 0; i < 4; ++i) { const int pos = j * 64 + kt * 16 + q4 * 4 + i;
                        const bool valid = (pos <= t) && (MODE == 0 || pos > t - 512); s[kt][i] = valid ? s[kt][i] : NINF; }
            }
            if (FAST) {
                const float mcp = rowsel ? mrow[rt] * CS : __builtin_inff();
                f32x4 ps4 = {0.f, 0.f, 0.f, 0.f};
#pragma unroll
                for (int kt = 0; kt < 4; ++kt) { f32x4 e = s[kt] * CS - mcp;
                    e[0] = __builtin_amdgcn_exp2f(e[0]); e[1] = __builtin_amdgcn_exp2f(e[1]); e[2] = __builtin_amdgcn_exp2f(e[2]); e[3] = __builtin_amdgcn_exp2f(e[3]); s[kt] = e; ps4 = ps4 + e; }
                lrow[rt] += (ps4[0] + ps4[1]) + (ps4[2] + ps4[3]);
            } else {
            f32x4 m4 = __builtin_elementwise_max(__builtin_elementwise_max(s[0], s[1]), __builtin_elementwise_max(s[2], s[3]));
            float mx = fmaxf(fmaxf(m4[0], m4[1]), fmaxf(m4[2], m4[3]));
            mx = fmaxf(mx, __shfl_xor(mx, 16)); mx = fmaxf(mx, __shfl_xor(mx, 32));
            const float mnew = fmaxf(mrow[rt], rowsel ? mx : NINF);
            const float mc = (mnew == NINF) ? 0.f : mnew * CS;
            const float alpha = __builtin_amdgcn_exp2f(mrow[rt] * CS - mc); mrow[rt] = mnew;
            const float mcp = rowsel ? mc : __builtin_inff();
            f32x4 ps4 = {0.f, 0.f, 0.f, 0.f};
#pragma unroll
            for (int kt = 0; kt < 4; ++kt) { f32x4 e = s[kt] * CS - mcp;
                e[0] = __builtin_amdgcn_exp2f(e[0]); e[1] = __builtin_amdgcn_exp2f(e[1]); e[2] = __builtin_amdgcn_exp2f(e[2]); e[3] = __builtin_amdgcn_exp2f(e[3]); s[kt] = e; ps4 = ps4 + e; }
            lrow[rt] = lrow[rt] * alpha + ((ps4[0] + ps4[1]) + (ps4[2] + ps4[3]));
#pragma unroll
            for (int dt = 0; dt < 4; ++dt) O[dt][rt] = O[dt][rt] * alpha;
            }
#pragma unroll
            for (int kk = 0; kk < 2; ++kk) { u32x4 t4; t4.x = pk2(s[2 * kk][0], s[2 * kk][1]); t4.y = pk2(s[2 * kk][2], s[2 * kk][3]);
                t4.z = pk2(s[2 * kk + 1][0], s[2 * kk + 1][1]); t4.w = pk2(s[2 * kk + 1][2], s[2 * kk + 1][3]); pb[rt][kk] = __builtin_bit_cast(bf16x8, t4); }
        }
#pragma unroll
        for (int kk = 0; kk < 2; ++kk) {
#pragma unroll
            for (int dt = 0; dt < 4; ++dt) {
                const u32x2 lo = *(const LAS u32x2*)(VbT + (dt * 16 + r16) * 72 + (2 * kk) * 16 + q4 * 4), hi = *(const LAS u32x2*)(VbT + (dt * 16 + r16) * 72 + (2 * kk + 1) * 16 + q4 * 4);
                u32x4 a4; a4.x = lo.x; a4.y = lo.y; a4.z = hi.x; a4.w = hi.y; const bf16x8 a = __builtin_bit_cast(bf16x8, a4);
#pragma unroll
                for (int rt = 0; rt < 2; ++rt) O[dt][rt] = MFMA16(a, pb[rt][kk], O[dt][rt]);
            }
        }
}

template <int MODE>
__device__ __forceinline__ void nsa_branch(const bf16_t* proj, LAS bf16_t* Kb0, LAS bf16_t* VbT0, int b, int g, int jt, int jlo, int jhi, unsigned umask, unsigned mk0, unsigned mk1,
                                           const bf16x8 (&bq)[2][2], f32x4 (&O)[4][2], float (&mrow)[2], float (&lrow)[2], int kcol, int vcol, bool fast) {
    const int tid = otid(), lane = tid & 63, w = tid >> 6, q4 = lane >> 4, r16 = lane & 15, th = w & 1;
    unsigned todo = (MODE == 0) ? umask : 0xffffffffu;
    todo &= (jhi >= 31 ? 0xffffffffu : ((1u << (jhi + 1)) - 1u)) & ~((1u << jlo) - 1u);
    const bf16_t* gbase = proj + (size_t)(b * TSEQ + lane) * LDP + g * 64 + w * 8;
    int j = todo ? __builtin_ctz(todo) : 64;
    u32x4 kv, vv;
    if (j < 64) { kv = *(const u32x4*)(gbase + (size_t)j * 64 * LDP + kcol); vv = *(const u32x4*)(gbase + (size_t)j * 64 * LDP + vcol); }
    LDS_BAR();
    int buf = 0;
    if (j < 64) { *(LAS u32x4*)(Kb0 + lane * 72 + w * 8) = kv;
#pragma unroll
        for (int e = 0; e < 4; ++e) { VbT0[(w * 8 + 2 * e) * 72 + lane] = (bf16_t)(vv[e] & 0xffffu); VbT0[(w * 8 + 2 * e + 1) * 72 + lane] = (bf16_t)(vv[e] >> 16); } }
    LDS_BAR();
    while (j < 64) {
        todo &= todo - 1u;
        const int jn = todo ? __builtin_ctz(todo) : 64;
        if (jn < 64) { kv = *(const u32x4*)(gbase + (size_t)jn * 64 * LDP + kcol); vv = *(const u32x4*)(gbase + (size_t)jn * 64 * LDP + vcol); }
        LAS bf16_t* Kb = Kb0 + buf * (2 * 64 * 72); LAS bf16_t* VbT = VbT0 + buf * (2 * 64 * 72);
        const bool need = (MODE == 1) || (__builtin_amdgcn_ballot_w64((((mk0 | mk1) >> j) & 1u) != 0u) != 0ull);
        const bool interior = (j < jt) && (MODE == 0 || j > jt - 8);
        if (need) {
            if (fast) {
                if (interior) nsa_step<MODE, false, true>(Kb, VbT, j, jt, th, q4, r16, mk0, mk1, bq, O, mrow, lrow);
                else { asm volatile("; boundary block" ::: "memory"); nsa_step<MODE, true, true>(Kb, VbT, j, jt, th, q4, r16, mk0, mk1, bq, O, mrow, lrow); }
            } else {
                asm volatile("; exact running-max path" ::: "memory");
                if (interior) nsa_step<MODE, false, false>(Kb, VbT, j, jt, th, q4, r16, mk0, mk1, bq, O, mrow, lrow);
                else { asm volatile("; boundary block" ::: "memory"); nsa_step<MODE, true, false>(Kb, VbT, j, jt, th, q4, r16, mk0, mk1, bq, O, mrow, lrow); }
            }
        }
        if (jn < 64) { LAS bf16_t* Kn = Kb0 + (buf ^ 1) * (2 * 64 * 72); LAS bf16_t* Vn = VbT0 + (buf ^ 1) * (2 * 64 * 72);
            *(LAS u32x4*)(Kn + lane * 72 + w * 8) = kv;
#pragma unroll
            for (int e = 0; e < 4; ++e) { Vn[(w * 8 + 2 * e) * 72 + lane] = (bf16_t)(vv[e] & 0xffffu); Vn[(w * 8 + 2 * e + 1) * 72 + lane] = (bf16_t)(vv[e] >> 16); } }
        LDS_BAR();
        j = jn; buf ^= 1;
    }
}

__device__ __forceinline__ void nsa_unit(const P& p, LAS unsigned char* lds, int b, int g, int jt) {
    const int tid = otid(), lane = tid & 63, w = tid >> 6, q4 = lane >> 4, r16 = lane & 15, hh = w >> 1, th = w & 1;
    const bf16_t* proj = p.big;
    LAS bf16_t* KC = (LAS bf16_t*)lds;
    LAS bf16_t* VCT = KC + 128 * 72;
    LAS float* impP = (LAS float*)(VCT + 64 * 136);
    LAS float* impS = impP + 4 * 64 * 33;
    LAS unsigned* selm = (LAS unsigned*)(impS + 64 * 33);
    LAS bf16_t* Kb = (LAS bf16_t*)(selm + 80);
    LAS bf16_t* VbT = Kb + 64 * 72;
    const int head = g * 4 + hh;
    bf16x8 bq[2][2];
#pragma unroll
    for (int rt = 0; rt < 2; ++rt)
#pragma unroll
        for (int ks = 0; ks < 2; ++ks) bq[rt][ks] = *(const bf16x8*)(proj + (size_t)(b * TSEQ + jt * 64 + th * 32 + rt * 16 + r16) * LDP + C_NQ + head * 64 + ks * 32 + q4 * 8);
    float qnorm[2];
#pragma unroll
    for (int rt = 0; rt < 2; ++rt) { float q2 = 0.f;
#pragma unroll
        for (int ks = 0; ks < 2; ++ks)
#pragma unroll
            for (int e = 0; e < 8; ++e) { const float qv = __uint_as_float(((unsigned)(unsigned short)bq[rt][ks][e]) << 16); q2 += qv * qv; }
        q2 += __shfl_xor(q2, 16); q2 += __shfl_xor(q2, 32); qnorm[rt] = sqrtf(q2); }
    bf16_t graw[2][3];
#pragma unroll
    for (int rt = 0; rt < 2; ++rt)
#pragma unroll
        for (int br = 0; br < 3; ++br) graw[rt][br] = proj[(size_t)(b * TSEQ + jt * 64 + th * 32 + rt * 16 + r16) * LDP + C_NG + head * 3 + br];
#define NSA_GATE(rt, br) sigmoidf_(bf2f(graw[rt][br]))
    __syncthreads();
    { const bf16_t* kc = p.KCb + (size_t)((0 * 16 + b) * 2 + g) * 128 * 64; const bf16_t* vc = p.KCb + (size_t)((1 * 16 + b) * 2 + g) * 128 * 64;
#pragma unroll
      for (int i = 0; i < 2; ++i) { const int row = tid & 127, c8 = ((tid >> 7) + 4 * i) * 8;
          const u32x4 kv = *(const u32x4*)(kc + row * 64 + c8); const u32x4 vv = *(const u32x4*)(vc + row * 64 + c8);
          *(LAS u32x4*)(KC + row * 72 + c8) = kv;
#pragma unroll
          for (int e = 0; e < 4; ++e) { VCT[(c8 + 2 * e) * 136 + row] = (bf16_t)(vv[e] & 0xffffu); VCT[(c8 + 2 * e + 1) * 136 + row] = (bf16_t)(vv[e] >> 16); } }
      if (tid == 0) selm[64] = 0u; }
    __syncthreads();
    f32x4 oacc[4][2];
#pragma unroll
    for (int rt = 0; rt < 2; ++rt) {
        f32x4 sa[8];
#pragma unroll
        for (int nt = 0; nt < 8; ++nt) {
            const bf16x8 a0 = *(const LAS bf16x8*)(KC + (nt * 16 + r16) * 72 + q4 * 8), a1 = *(const LAS bf16x8*)(KC + (nt * 16 + r16) * 72 + 32 + q4 * 8);
            f32x4 acc = {0.f, 0.f, 0.f, 0.f}; acc = MFMA16(a0, bq[rt][0], acc); acc = MFMA16(a1, bq[rt][1], acc); sa[nt] = acc;
        }
        const int t = jt * 64 + th * 32 + rt * 16 + r16; const int nval = (t >= 31) ? ((t - 31) / 16 + 1) : 0;
        float mx = -1e30f;
#pragma unroll
        for (int nt = 0; nt < 8; ++nt)
#pragma unroll
            for (int i = 0; i < 4; ++i) { const int n = nt * 16 + q4 * 4 + i; const float sv = (n < nval) ? sa[nt][i] * 0.125f : -1e30f; sa[nt][i] = sv; mx = fmaxf(mx, sv); }
        mx = fmaxf(mx, __shfl_xor(mx, 16)); mx = fmaxf(mx, __shfl_xor(mx, 32));
        float sum = 0.f;
#pragma unroll
        for (int nt = 0; nt < 8; ++nt)
#pragma unroll
            for (int i = 0; i < 4; ++i) { const float sv = sa[nt][i]; const float pv = (sv > -1e29f) ? fexp(sv - mx) : 0.f; sa[nt][i] = pv; sum += pv; }
        sum += __shfl_xor(sum, 16); sum += __shfl_xor(sum, 32);
        const float inv = sum > 0.f ? frcp(sum) : 0.f;
#pragma unroll
        for (int nt = 0; nt < 8; ++nt) sa[nt] = sa[nt] * inv;
        float sh[8];
#pragma unroll
        for (int nt = 0; nt < 8; ++nt) sh[nt] = __shfl(0.5f * sa[nt][3], (lane + 48) & 63);
#pragma unroll
        for (int nt = 0; nt < 8; ++nt) { const float own = (sa[nt][0] + sa[nt][1]) + (sa[nt][2] + 0.5f * sa[nt][3]);
            const float spin = (q4 > 0) ? sh[nt] : (nt > 0 ? sh[nt > 0 ? nt - 1 : 0] : 0.f);
            impP[(hh * 64 + th * 32 + rt * 16 + r16) * 33 + nt * 4 + q4] = own + spin; }
        f32x4 oc[4];
#pragma unroll
        for (int dt = 0; dt < 4; ++dt) oc[dt] = (f32x4){0.f, 0.f, 0.f, 0.f};
#pragma unroll
        for (int kk = 0; kk < 4; ++kk) {
            u32x4 t4; t4.x = pk2(sa[2 * kk][0], sa[2 * kk][1]); t4.y = pk2(sa[2 * kk][2], sa[2 * kk][3]);
            t4.z = pk2(sa[2 * kk + 1][0], sa[2 * kk + 1][1]); t4.w = pk2(sa[2 * kk + 1][2], sa[2 * kk + 1][3]); const bf16x8 pb = __builtin_bit_cast(bf16x8, t4);
#pragma unroll
            for (int dt = 0; dt < 4; ++dt) {
                const u32x2 lo = *(const LAS u32x2*)(VCT + (dt * 16 + r16) * 136 + (2 * kk) * 16 + q4 * 4), hi = *(const LAS u32x2*)(VCT + (dt * 16 + r16) * 136 + (2 * kk + 1) * 16 + q4 * 4);
                u32x4 a4; a4.x = lo.x; a4.y = lo.y; a4.z = hi.x; a4.w = hi.y; const bf16x8 a = __builtin_bit_cast(bf16x8, a4);
                oc[dt] = MFMA16(a, pb, oc[dt]);
            }
        }
        const float g0 = NSA_GATE(rt, 0);
#pragma unroll
        for (int dt = 0; dt < 4; ++dt) oacc[dt][rt] = oc[dt] * g0;
    }
    __syncthreads();
    { const int tok = tid >> 3, part = tid & 7;
#pragma unroll
      for (int i = 0; i < 4; ++i) { const int jb = part * 4 + i;
          impS[tok * 33 + jb] = ((impP[(0 * 64 + tok) * 33 + jb] + impP[(1 * 64 + tok) * 33 + jb]) + impP[(2 * 64 + tok) * 33 + jb]) + impP[(3 * 64 + tok) * 33 + jb]; }
      __syncthreads();
      unsigned bits = 0u;
      if (jt >= 16) {
          float v[32];
#pragma unroll
          for (int j2 = 0; j2 < 32; ++j2) v[j2] = impS[tok * 33 + j2];
#pragma unroll
          for (int i = 0; i < 4; ++i) { const int jb = part * 4 + i;
              const bool forced = (jb == 0) || (jb == jt) || (jb == jt - 1);
              const float vb = impS[tok * 33 + jb]; int rank = 0;
#pragma unroll
              for (int j2 = 1; j2 < 31; ++j2) rank += ((j2 <= jt - 2) && (v[j2] > vb || (v[j2] == vb && j2 < jb))) ? 1 : 0;
              if (forced || (jb >= 1 && jb <= jt - 2 && rank < 13)) bits |= 1u << jb; }
      } else {
#pragma unroll
          for (int i = 0; i < 4; ++i) { const int jb = part * 4 + i; if (jb <= jt) bits |= 1u << jb; }
      }
      bits |= __shfl_xor(bits, 1); bits |= __shfl_xor(bits, 2); bits |= __shfl_xor(bits, 4);
      if (part == 0) { selm[tok] = bits; atomicOr((unsigned*)(selm + 64), bits); }
    }
    __syncthreads();
    const unsigned umask = selm[64], mk0 = selm[th * 32 + r16], mk1 = selm[th * 32 + 16 + r16];
    LAS float* stash = (LAS float*)lds + w * 2048 + lane;
#pragma unroll
    for (int dt = 0; dt < 4; ++dt)
#pragma unroll
        for (int rt = 0; rt < 2; ++rt)
#pragma unroll
            for (int i = 0; i < 4; ++i) stash[((dt * 2 + rt) * 4 + i) * 64] = oacc[dt][rt][i];
#pragma unroll
    for (int br = 0; br < 2; ++br) {
        f32x4 O[4][2]; float mrow[2], lrow[2] = {0.f, 0.f};
        const float kmax = sqrtf(__uint_as_float(p.kmx[(b * 2 + g) * 2 + br]));
        const float bnd0 = qnorm[0] * kmax * 1.002f + 0.1f, bnd1 = qnorm[1] * kmax * 1.002f + 0.1f;
        const bool fast = __builtin_amdgcn_ballot_w64(!(bnd0 * 0.125f <= 40.f && bnd1 * 0.125f <= 40.f)) == 0ull;
        mrow[0] = fast ? bnd0 : -__builtin_inff(); mrow[1] = fast ? bnd1 : -__builtin_inff();
#pragma unroll
        for (int dt = 0; dt < 4; ++dt) { O[dt][0] = (f32x4){0.f, 0.f, 0.f, 0.f}; O[dt][1] = (f32x4){0.f, 0.f, 0.f, 0.f}; }
#ifndef NO_BR
        if (br == 0) nsa_branch<0>(proj, Kb, VbT, b, g, jt, 0, jt, umask, mk0, mk1, bq, O, mrow, lrow, C_KS, C_VS, fast);
        else nsa_branch<1>(proj, Kb, VbT, b, g, jt, (jt >= 8 ? jt - 8 : 0), jt, umask, mk0, mk1, bq, O, mrow, lrow, C_KW, C_VW, fast);
#endif
#pragma unroll
        for (int rt = 0; rt < 2; ++rt) { float l = lrow[rt]; l += __shfl_xor(l, 16); l += __shfl_xor(l, 32);
            const float sc = (l > 0.f) ? NSA_GATE(rt, br + 1) * frcp(l) : 0.f;
#pragma unroll
            for (int dt = 0; dt < 4; ++dt) { f32x4 v = O[dt][rt] * sc;
#pragma unroll
                for (int i = 0; i < 4; ++i) v[i] += stash[((dt * 2 + rt) * 4 + i) * 64];
                if (br == 0) {
#pragma unroll
                    for (int i = 0; i < 4; ++i) stash[((dt * 2 + rt) * 4 + i) * 64] = v[i];
                } else { u32x2 wv; wv.x = pk2(v[0], v[1]); wv.y = pk2(v[2], v[3]);
                    *(u32x2*)(p.A2 + (size_t)(b * TSEQ + jt * 64 + th * 32 + rt * 16 + r16) * DM + 512 + head * 64 + dt * 16 + q4 * 4) = wv; } } }
    }
}

__device__ __forceinline__ void phase_final(const P& p) {
    const int tid = otid(), lane = tid & 63; const int gw = blockIdx.x * 8 + (tid >> 6), NGW = gridDim.x * 8;
    f32x4 gq[4];
#pragma unroll
    for (int j = 0; j < 4; ++j) gq[j] = *((const f32x4*)p.fnorm + lane + 64 * j);
    for (int row0 = gw; row0 < MTOK; row0 += 4 * NGW) {
        u32x2 rb[4][4]; float rs[4];
#pragma unroll
        for (int r = 0; r < 4; ++r) { const int row = row0 + r * NGW; if (row < MTOK) { const u32x2* xi = (const u32x2*)(p.xb + (size_t)row * DM) + lane;
#pragma unroll
            for (int j = 0; j < 4; ++j) rb[r][j] = __builtin_nontemporal_load(xi + 64 * j);
            rs[r] = rsqrtf(p.ssq[3 * MTOK + row] * (1.0f / DM) + EPS); } }
#pragma unroll
        for (int r = 0; r < 4; ++r) { const int row = row0 + r * NGW; if (row < MTOK) { f32x4* o = (f32x4*)(p.out + (size_t)row * DM) + lane;
#pragma unroll
            for (int j = 0; j < 4; ++j) { f32x4 v;
                v[0] = __uint_as_float(rb[r][j].x << 16); v[1] = __uint_as_float(rb[r][j].x & 0xffff0000u); v[2] = __uint_as_float(rb[r][j].y << 16); v[3] = __uint_as_float(rb[r][j].y & 0xffff0000u);
                __builtin_nontemporal_store(v * rs[r] * gq[j], o + 64 * j); } } }
    }
}

#define XB_TMO      128
#define XB_XCNT(j)  (256  + 64 * (j))
#define XB_XSUB(j)  (1280 + 64 * (j))
#define XB_XGEN(j)  (2304 + 64 * (j))
#define XB_TOP      3328
#define XB_TOPGEN   3392
#define XCD_BAR_WORDS 3456
#define XB_SPIN_CAP (1u << 18)
__device__ __forceinline__ unsigned xb_ld(unsigned* p)              { return __hip_atomic_load(p, __ATOMIC_RELAXED, __HIP_MEMORY_SCOPE_AGENT); }
__device__ __forceinline__ unsigned xb_add(unsigned* p, unsigned v) { return __hip_atomic_fetch_add(p, v, __ATOMIC_RELAXED, __HIP_MEMORY_SCOPE_AGENT); }
__device__ __forceinline__ unsigned xb_xcc_id() { return (unsigned)__builtin_amdgcn_s_getreg((3 << 11) | 20) & 0xFu; }
#define XB_SPIN(cond, bar) do { unsigned _sp = 0; while (cond) { __builtin_amdgcn_s_sleep(1); \
    if ((++_sp & 255u) == 0u) { if (xb_ld(&(bar)[XB_TMO])) break; if (_sp > XB_SPIN_CAP) { atomicAdd(&(bar)[XB_TMO], 1u); break; } } } } while (0)
struct XcdBarrier { unsigned* bar; unsigned x; volatile LAS unsigned* st; };
__device__ __forceinline__ XcdBarrier xcd_barrier_post(unsigned* bar, volatile LAS unsigned* st) {
    XcdBarrier b; b.bar = bar; b.x = xb_xcc_id(); b.st = st;
    if (threadIdx.x == 0) (void)xb_add(&bar[XB_XCNT(b.x)], 1u);
    return b;
}
__device__ __forceinline__ void xcd_barrier_complete(unsigned* bar, unsigned x, unsigned& nloc, unsigned& nx) {
    const unsigned G = gridDim.x * gridDim.y * gridDim.z;
    unsigned sum, cnt, mine, sp = 0u;
    for (;;) {
        sum = 0u; cnt = 0u; mine = 0u;
#pragma unroll
        for (unsigned j = 0; j < 16; ++j) { const unsigned c = xb_ld(&bar[XB_XCNT(j)]); sum += c; cnt += (c > 0u) ? 1u : 0u; mine = (j == x) ? c : mine; }
        if (sum == G) break;
        __builtin_amdgcn_s_sleep(1);
        if ((++sp & 255u) == 0u) { if (xb_ld(&bar[XB_TMO])) break; if (sp > XB_SPIN_CAP) { atomicAdd(&bar[XB_TMO], 1u); break; } }
    }
    nloc = mine > 0u ? mine : 1u; nx = cnt > 0u ? cnt : 1u;
}
__device__ __forceinline__ void xcd_barrier(const XcdBarrier& b) {
    asm volatile("s_waitcnt vmcnt(0)" ::: "memory");
    __syncthreads();
    if (threadIdx.x == 0) {
        unsigned* bar = b.bar;
        __builtin_amdgcn_s_waitcnt(0);
        unsigned nloc = b.st[0], nx = b.st[1];
        if (nloc == 0u) { xcd_barrier_complete(bar, b.x, nloc, nx); b.st[0] = nloc; b.st[1] = nx; }
        const unsigned old = xb_add(&bar[XB_XSUB(b.x)], 1u);
        const unsigned gen = old / nloc;
        if (old + 1u == (gen + 1u) * nloc) {
            __builtin_amdgcn_fence(__ATOMIC_RELEASE, "agent");
            asm volatile("s_waitcnt vmcnt(0)" ::: "memory");
            const unsigned og = xb_add(&bar[XB_TOP], 1u);
            const unsigned tg = og / nx;
            if (og + 1u == (tg + 1u) * nx) xb_add(&bar[XB_TOPGEN], 1u);
            else XB_SPIN(xb_ld(&bar[XB_TOPGEN]) == tg, bar);
            __builtin_amdgcn_fence(__ATOMIC_ACQUIRE, "agent");
            xb_add(&bar[XB_XGEN(b.x)], 1u);
            asm volatile("s_waitcnt vmcnt(0)" ::: "memory");
        } else {
            XB_SPIN(xb_ld(&bar[XB_XGEN(b.x)]) == gen, bar);
            __builtin_amdgcn_fence(__ATOMIC_ACQUIRE, "agent");
            asm volatile("s_waitcnt vmcnt(0)" ::: "memory");
        }
    }
    __syncthreads();
}

constexpr int NPHASE = 11;
#ifndef PH_MASK
#define PH_MASK 0x7ff
#endif
template <int ph>
__device__ __forceinline__ void run_phase(const P& p, LAS unsigned char* lds) {
    if (!((PH_MASK >> ph) & 1)) return;
    const int G = gridDim.x, c = blockIdx.x;
    pg8::Order S; S.G = G; S.c = c; S.nZ = 1; S.az0 = S.az1 = S.bz1 = 0;
    switch (ph) {
    case 0: phase_prep(p, lds); break;
    case 1: case 8: {
        S.nM = MTOK / 256; S.nN = 22; S.A = (const char*)p.xb; S.Bt = (const char*)(ph == 1 ? p.Wup1 : p.Wup2); S.a_tile = (size_t)256 * DM * 2; S.b_tile = (size_t)256 * DM * 2;
        EpiUp E{p.big, p.ssq + (ph == 1 ? 0 : 2) * MTOK};
        pg8::gemm_phase(lds, pg8::Dims{DM, DM, 64}, S, E); } break;
    case 2: case 9: {
        S.nM = MTOK / 256; S.nN = 4; S.A = (const char*)p.big; S.Bt = (const char*)(ph == 2 ? p.Wdn1 : p.Wdn2); S.a_tile = (size_t)256 * FF * 2; S.b_tile = (size_t)256 * FF * 2;
        EpiRes E{(const float*)nullptr, p.xb, p.ssq + (ph == 2 ? 1 : 3) * MTOK, 0.5f};
        pg8::gemm_phase<EpiRes, true>(lds, pg8::Dims{FF, 64, 256 * 64}, S, E); } break;
    case 3: {
        S.nM = MTOK / 256; S.nN = 14; S.A = (const char*)p.xb; S.Bt = (const char*)p.Wint; S.a_tile = (size_t)256 * DM * 2; S.b_tile = (size_t)256 * DM * 2;
        EpiProj E{p.big, p.ssq + MTOK};
        pg8::gemm_phase(lds, pg8::Dims{DM, DM, 64}, S, E); } break;
    case 4: {
        S.nM = 8; S.nN = 2; S.nZ = 4; S.A = (const char*)(p.big + C_KC); S.Bt = (const char*)p.Wc1t;
        S.az0 = 64 * 2; S.az1 = 128 * 2; S.bz1 = (size_t)512 * 1024 * 2; S.a_tile = (size_t)256 * 16 * LDP * 2; S.b_tile = (size_t)256 * 1024 * 2;
        EpiUV E{p.UV};
        if (G > 128) {
            if (c < 64) { pg8::gemm_phase(lds, pg8::Dims{1024, 16 * LDP, LDP}, S, E); phase_prep_late(p, lds, c, 64, 1000, 1 << 30); }
            else { phase_kmax(p, c - 64, G - 64); phase_gates(p, c - 64, G - 64); phase_conv(p, c - 64, G - 64); phase_prep_late(p, lds, c - 64, G - 64, 0, 1000); }
        } else { pg8::gemm_phase(lds, pg8::Dims{1024, 16 * LDP, LDP}, S, E); phase_prep_late(p, lds, c, G, 0, 1 << 30); phase_kmax(p, c, G); phase_gates(p, c, G); phase_conv(p, c, G); } } break;
    case 5: {
        phase_cmp2(p, lds);
        if (G == 256) { const int x = c & 7, m = c >> 3; mlstm_unit(p, lds, ((x * 8 + (m >> 2)) << 2) | (m & 3)); }
        else for (int u = c; u < 256; u += G) mlstm_unit(p, lds, u); } break;
    case 6: {
        phase_mlstm_fin(p);
#ifndef NSA_REP
#define NSA_REP 1
#endif
        for (int rep = 0; rep < NSA_REP; ++rep)
        if (G == 256) {
            const int x = c & 7, m = c >> 3;
            for (int i = 0; i < 4; ++i) { const int bg = x * 4 + i; const int mm = (i & 2) ? ((m + 16) & 31) : m; const int jt = (i & 1) ? 31 - mm : mm;
                nsa_unit(p, lds, bg >> 1, bg & 1, jt); }
        } else
        for (int i = 0; c + i * G < 1024; ++i) { const int u = c + i * G; const int k = u >> 5, bg = u & 31;
            const int rnd = k >> 3, kk = k & 7; const int jt = (rnd == 0) ? 31 - kk : (rnd == 1) ? 16 + kk : (rnd == 2) ? 15 - kk : kk;
            nsa_unit(p, lds, bg >> 1, bg & 1, jt); } } break;
    case 7: {
        S.nM = MTOK / 256; S.nN = 4; S.A = (const char*)p.A2; S.Bt = (const char*)p.Woutt; S.a_tile = (size_t)256 * DM * 2; S.b_tile = (size_t)256 * DM * 2;
        EpiRes E{(const float*)nullptr, p.xb, p.ssq + 2 * MTOK, 1.0f};
        pg8::gemm_phase(lds, pg8::Dims{DM, DM, 64}, S, E); } break;
    case 10: phase_final(p); break;
    }
}

__global__ __launch_bounds__(512) void mega(P p, int ph_lo, int ph_hi) {
    extern __shared__ __attribute__((aligned(16))) unsigned char shm[];
    LAS unsigned char* lds = (LAS unsigned char*)shm;
#if ONE_LAUNCH
    cg::grid_group grid = cg::this_grid();
    if (ph_lo < 0) grid.sync();
    volatile LAS unsigned* st = (volatile LAS unsigned*)(lds + 131072);
    if (threadIdx.x == 0) { st[0] = 0u; st[1] = 0u; st[2] = 0u; st[3] = 0u; }
    __syncthreads();
    const XcdBarrier xb = xcd_barrier_post(p.bar, st);
#ifndef REP_MASK
#define REP_MASK 0
#endif
#define RUNPH(k) if (ph_lo <= k && k <= ph_hi) { run_phase<k>(p, lds); if ((REP_MASK >> k) & 1) { xcd_barrier(xb); run_phase<k>(p, lds); } if (k < ph_hi) xcd_barrier(xb); }
#else
#define RUNPH(k) if (ph_lo <= k && k <= ph_hi) { run_phase<k>(p, lds); }
#endif
    RUNPH(0) RUNPH(1) RUNPH(2) RUNPH(3) RUNPH(4) RUNPH(5) RUNPH(6) RUNPH(7) RUNPH(8) RUNPH(9) RUNPH(10)
}

extern "C" void kernel_launch(void* const* d_in, const int* in_sizes, int n_in, void* d_out, int out_size, void* d_ws, size_t ws_size, hipStream_t stream) {
    constexpr size_t LDS_BYTES = 131072 + 16;
    static int grid = 0;
    if (grid == 0) {
        int dev = 0, cus = 0, per_cu = 0;
        hipGetDevice(&dev); hipDeviceGetAttribute(&cus, hipDeviceAttributeMultiprocessorCount, dev);
        hipFuncSetAttribute((const void*)mega, hipFuncAttributeMaxDynamicSharedMemorySize, (int)LDS_BYTES);
        hipOccupancyMaxActiveBlocksPerMultiprocessor(&per_cu, (const void*)mega, 512, LDS_BYTES);
        if (per_cu < 1) { fprintf(stderr, "occupancy query says %d blocks per CU\n", per_cu); per_cu = 1; }
        grid = cus * 1;
        (void)hipGetLastError();
    }
    P p{};
    const float** f = (const float**)d_in;
    p.x = f[0]; p.f1n = f[1]; p.f1w1 = f[2]; p.f1w3 = f[3]; p.f1w2 = f[4]; p.mixn = f[5]; p.win = f[6]; p.convw = f[7]; p.mlbi = f[8]; p.mlbf = f[9]; p.mlgn = f[10];
    p.kpe = f[11]; p.kw1 = f[12]; p.kb1 = f[13]; p.kw2 = f[14]; p.vpe = f[15]; p.vw1 = f[16]; p.vb1 = f[17]; p.vw2 = f[18]; p.wout = f[19];
    p.f2n = f[20]; p.f2w1 = f[21]; p.f2w3 = f[22]; p.f2w2 = f[23]; p.fnorm = f[24];
    p.out = (float*)d_out;
    char* ws = (char*)d_ws; size_t off = 0;
    auto take = [&](size_t bytes) { char* r = ws + off; off += (bytes + 255) & ~(size_t)255; return r; };
    p.Wup1 = (bf16_t*)take((size_t)5632 * 1024 * 2); p.Wdn1 = (bf16_t*)take((size_t)1024 * FF * 2);
    p.Wup2 = (bf16_t*)take((size_t)5632 * 1024 * 2); p.Wdn2 = (bf16_t*)take((size_t)1024 * FF * 2);
    p.Wint = (bf16_t*)take((size_t)LDP * 1024 * 2); p.Woutt = (bf16_t*)take((size_t)1024 * 1024 * 2); p.Wc1t = (bf16_t*)take((size_t)2 * 512 * 1024 * 2);
    p.xb = (bf16_t*)take((size_t)MTOK * DM * 2);
    p.big = (bf16_t*)take((size_t)MTOK * LDP * 2);
    p.A2 = (bf16_t*)take((size_t)MTOK * DM * 2);
    p.ssq = (float*)take((size_t)4 * MTOK * 4);
    p.UV = (float*)take((size_t)4 * 2048 * 512 * 4);
    p.b1f = (float*)take(512 * 4);
    p.KCb = (bf16_t*)take((size_t)2 * 16 * 2 * 128 * 64 * 2);
    p.kmx = (unsigned*)take(64 * 4);
    p.gat = (float*)take((size_t)64 * TSEQ * 16);
    p.qkc = (bf16_t*)take((size_t)MTOK * DM * 2);
    p.bar = (unsigned*)take(XCD_BAR_WORDS * 4);
    if (off > ws_size) { fprintf(stderr, "workspace too small: need %zu have %zu\n", off, ws_size); return; }
#if ONE_LAUNCH
    hipMemsetAsync(p.bar, 0, XCD_BAR_WORDS * 4, stream);
    int lo = 0, hi = NPHASE - 1;
    void* args[] = {&p, &lo, &hi};
    hipError_t e = hipLaunchCooperativeKernel((const void*)mega, dim3(grid), dim3(512), args, LDS_BYTES, stream);
    if (e != hipSuccess) fprintf(stderr, "cooperative launch failed: %s (grid %d)\n", hipGetErrorString(e), grid);
#else
    for (int ph = 0; ph < NPHASE; ++ph) mega<<<dim3(grid), dim3(512), LDS_BYTES, stream>>>(p, ph, ph);
#endif
}
```
